# Optimizing an MI355X kernel written in HIP

```python
import jax
import jax.numpy as jnp
from jax import lax
import numpy as np

D_MODEL = 2048
BATCH = 4
SEQ = 4096
DEPTH = 2

GRID_W = 64
CTX_LEN = 256
F32 = jnp.float32
NORM_EPS = 1e-6

N_Q_HEADS = 8
N_KV_HEADS = 2
HEAD_DIM = 128
ATTN_W = N_Q_HEADS * HEAD_DIM
KV_W = N_KV_HEADS * HEAD_DIM
ROPE_THETA = 10000.0
Q_BLOCK = 128
ATTN_SCALE = HEAD_DIM ** -0.5

POOL_WINDOWS = (2, 4, 8, 16)
POOL_GROUPS = len(POOL_WINDOWS)
POOL_W = 1024
POOL_GW = POOL_W // POOL_GROUPS

RWKV_W = 1024
RWKV_HEAD = 64
RWKV_HEADS = RWKV_W // RWKV_HEAD
DECAY_LORA = 64
AAA_LORA = 64
GATE_LORA = 320
N_DIR = 2
GN_EPS = 64e-5

N_BRANCH = 3

N_EXPERTS = 16
EC_FACTOR = 2
EXPERT_FF = 1024

COL_Q = 0
COL_K = COL_Q + ATTN_W
COL_V = COL_K + KV_W
COL_POOL = COL_V + KV_W
COL_R = COL_POOL + POOL_W
COL_GATE = COL_R + 3 * RWKV_W + N_DIR * DECAY_LORA + N_DIR * AAA_LORA + GATE_LORA
N_SHIFT = COL_GATE - COL_R
N_IN = COL_GATE + N_BRANCH * D_MODEL

kernel_name = 'hybrid_gqa_pool_rwkv7_ec_moe_prefix_dit'


def rms_norm(x, g):
    xf = x.astype(F32)
    y = xf * lax.rsqrt(jnp.mean(xf * xf, axis=-1, keepdims=True) + NORM_EPS)
    return (y * g.astype(F32)).astype(x.dtype)


def modulated_norm(x, g, shift, scale):
    return rms_norm(x, g) * (1.0 + scale) + shift


def axial_rope_tables(n_lat):
    rows = n_lat // GRID_W
    row = jnp.repeat(jnp.arange(rows), GRID_W).astype(F32)
    col = (jnp.arange(rows * GRID_W) % GRID_W).astype(F32)
    half = HEAD_DIM // 2
    inv = ROPE_THETA ** (-jnp.arange(0, half, 2, dtype=F32) / half)
    ang = jnp.stack([row[:, None] * inv, col[:, None] * inv], axis=1)
    return jnp.cos(ang), jnp.sin(ang)


def apply_axial_rope(x, cos, sin):
    lead = x.shape[:-1]
    xs = x.astype(F32).reshape(lead + (2, 2, HEAD_DIM // 4))
    bshape = (1, x.shape[1]) + (1,) * (x.ndim - 3) + (2, HEAD_DIM // 4)
    cs, sn = cos.reshape(bshape), sin.reshape(bshape)
    x1, x2 = xs[..., 0, :], xs[..., 1, :]
    out = jnp.stack([x1 * cs - x2 * sn, x2 * cs + x1 * sn], axis=-2)
    return out.reshape(x.shape).astype(x.dtype)


def blocked_attention(q, k, v):
    B, Tq = q.shape[:2]
    nb = Tq // Q_BLOCK
    qb = jnp.swapaxes(q.reshape((B, nb, Q_BLOCK) + q.shape[2:]), 0, 1)

    def one_block(qblk):
        s = jnp.einsum('bqkgd,bskd->bkgqs', qblk, k).astype(F32) * ATTN_SCALE
        pr = jax.nn.softmax(s, axis=-1).astype(v.dtype)
        return jnp.einsum('bkgqs,bskd->bqkgd', pr, v)

    o = lax.map(one_block, qb)
    return jnp.swapaxes(o, 0, 1).reshape(B, Tq, ATTN_W)


def multiscale_pool(u, w_group, scale):
    B, T, _ = u.shape
    uf = u.astype(F32).reshape(B, T, POOL_GROUPS, POOL_GW)
    cs = jnp.pad(jnp.cumsum(uf, axis=1), ((0, 0), (1, 0), (0, 0), (0, 0)))
    t = jnp.arange(T)
    groups = []
    for gi, win in enumerate(POOL_WINDOWS):
        lo = jnp.clip(t - win // 2, 0, T)
        hi = jnp.clip(t + win - win // 2, 0, T)
        csg = cs[:, :, gi]
        mean = (csg[:, hi] - csg[:, lo]) / (hi - lo).astype(F32)[None, :, None]
        groups.append(mean - uf[:, :, gi])
    pooled = jnp.stack(groups, axis=2).astype(u.dtype)
    y = jnp.einsum('btgc,gcd->btgd', pooled, w_group).reshape(B, T, POOL_W)
    return y * scale


def token_shift(u, mu):
    prev = jnp.pad(u[:, :-1], ((0, 0), (1, 0), (0, 0)))
    nxt = jnp.pad(u[:, 1:], ((0, 0), (0, 1), (0, 0)))
    return u + (0.5 * (prev + nxt) - u) * mu


def _rwkv7_step(state, inp):
    r, w, k, v, kk, b = inp
    sa = jnp.einsum('bhij,bhj->bhi', state, -kk)
    state = state * w[:, :, None, :] + sa[..., None] * b[:, :, None, :] + v[..., None] * k[:, :, None, :]
    return state, jnp.einsum('bhij,bhj->bhi', state, r)


def rwkv7_mixer(u, n_ctx, mu, w0, w2, a0, a2, g2, k_k, k_a, r_k, ln_w, ln_b):
    B, T, _ = u.shape
    u = jnp.concatenate([token_shift(u[:, :n_ctx], mu), token_shift(u[:, n_ctx:], mu)], axis=1)
    o1 = 3 * RWKV_W
    o2 = o1 + N_DIR * DECAY_LORA
    o3 = o2 + N_DIR * AAA_LORA
    r, k, v, wd, ad, gd = jnp.split(u, [RWKV_W, 2 * RWKV_W, o1, o2, o3], axis=-1)
    wd = wd.reshape(B, T, N_DIR, DECAY_LORA)
    ad = ad.reshape(B, T, N_DIR, AAA_LORA)
    w_log = -jax.nn.softplus(-(w0 + jnp.einsum('btzr,zrc->btzc', jnp.tanh(wd), w2))) - 0.5
    decay = jnp.exp(-jnp.exp(w_log.astype(F32)))
    a = jax.nn.sigmoid(a0 + jnp.einsum('btzr,zrc->btzc', ad, a2)).astype(F32)
    g = jax.nn.sigmoid(gd) @ g2

    def heads(z):
        return z.reshape(z.shape[:-1] + (RWKV_HEADS, RWKV_HEAD))

    rf, kf, vf = r.astype(F32), k.astype(F32), v.astype(F32)
    kk = heads(kf * k_k)
    kk = kk / jnp.maximum(jnp.sqrt(jnp.sum(kk * kk, axis=-1, keepdims=True)), 1e-12)
    k_dir = heads(kf[:, :, None] * (1.0 + (a - 1.0) * k_a))
    b_dir = kk[:, :, None] * heads(a)
    decay = heads(decay)
    r_h, v_h = heads(rf), heads(vf)

    s0 = jnp.zeros((B, RWKV_HEADS, RWKV_HEAD, RWKV_HEAD), F32)
    y = 0.0
    for d, rev in enumerate((False, True)):
        seq = tuple(jnp.moveaxis(z, 1, 0) for z in
                    (r_h, decay[:, :, d], k_dir[:, :, d], v_h, kk, b_dir[:, :, d]))
        s_ctx, y_ctx = lax.scan(_rwkv7_step, s0, tuple(z[:n_ctx] for z in seq), reverse=rev)
        _, y_lat = lax.scan(_rwkv7_step, s_ctx, tuple(z[n_ctx:] for z in seq), reverse=rev)
        y = y + jnp.concatenate([y_ctx, y_lat], axis=0)
    y = jnp.moveaxis(y, 0, 1)
    mean = jnp.mean(y, axis=-1, keepdims=True)
    var = jnp.mean(jnp.square(y - mean), axis=-1, keepdims=True)
    yn = ((y - mean) * lax.rsqrt(var + GN_EPS)).reshape(B, T, RWKV_W) * ln_w + ln_b
    bonus = jnp.sum(jnp.sum(r_h[:, :, None] * k_dir * r_k, axis=-1), axis=2)[..., None] * v_h
    out = (yn + bonus.reshape(B, T, RWKV_W)) * g
    return out.astype(u.dtype)


def token_mixing(p, n_ctx, cos, sin, keep_ctx, q_norm, k_norm, w_attn_o, w_pool_group, pool_scale, w_pool_o,
                 rwkv_mu, rwkv_w0, rwkv_w2, rwkv_a0, rwkv_a2, rwkv_g2, rwkv_k_k, rwkv_k_a, rwkv_r_k,
                 rwkv_ln_w, rwkv_ln_b, w_rwkv_o, w_out):
    B, T, _ = p.shape
    G = N_Q_HEADS // N_KV_HEADS
    q = rms_norm(p[..., COL_Q:COL_K].reshape(B, T, N_KV_HEADS, G, HEAD_DIM), q_norm)
    k = rms_norm(p[..., COL_K:COL_V].reshape(B, T, N_KV_HEADS, HEAD_DIM), k_norm)
    v = p[..., COL_V:COL_POOL].reshape(B, T, N_KV_HEADS, HEAD_DIM)
    q_lat = apply_axial_rope(q[:, n_ctx:], cos, sin)
    k_lat = apply_axial_rope(k[:, n_ctx:], cos, sin)
    k_all = jnp.concatenate([k_lat, k[:, :n_ctx]], axis=1)
    v_all = jnp.concatenate([v[:, n_ctx:], v[:, :n_ctx]], axis=1)
    attn = blocked_attention(q_lat, k_all, v_all)
    u_pool = p[..., COL_POOL:COL_R]
    pool = multiscale_pool(u_pool[:, n_ctx:], w_pool_group, pool_scale)
    rwkv = rwkv7_mixer(p[..., COL_R:COL_GATE], n_ctx, rwkv_mu, rwkv_w0, rwkv_w2, rwkv_a0, rwkv_a2, rwkv_g2,
                       rwkv_k_k, rwkv_k_a, rwkv_r_k, rwkv_ln_w, rwkv_ln_b)
    if keep_ctx:
        attn = jnp.concatenate([blocked_attention(q[:, :n_ctx], k[:, :n_ctx], v[:, :n_ctx]), attn], axis=1)
        pool = jnp.concatenate([multiscale_pool(u_pool[:, :n_ctx], w_group=w_pool_group, scale=pool_scale), pool], axis=1)
        start = 0
    else:
        rwkv = rwkv[:, n_ctx:]
        start = n_ctx
    gates = jax.nn.sigmoid(p[:, start:, COL_GATE:].reshape(B, T - start, N_BRANCH, D_MODEL))
    merged = (gates[:, :, 0] * (attn @ w_attn_o) + gates[:, :, 1] * (pool @ w_pool_o)
              + gates[:, :, 2] * (rwkv @ w_rwkv_o))
    return merged @ w_out


def expert_choice_ffn(h, w_router, w_gate, w_up, w_down):
    B, n, D = h.shape
    cap = EC_FACTOR * n // N_EXPERTS
    aff = jax.nn.softmax(jnp.einsum('bnd,de->bne', h, w_router).astype(F32), axis=-1)
    top_aff, idx = lax.top_k(jnp.swapaxes(aff, 1, 2), cap)
    xe = jax.vmap(lambda hb, ib: hb[ib])(h, idx)
    hid = jax.nn.silu(jnp.einsum('becd,edf->becf', xe, w_gate)) * jnp.einsum('becd,edf->becf', xe, w_up)
    ye = jnp.einsum('becf,efd->becd', hid, w_down) * top_aff[..., None].astype(h.dtype)
    return jax.vmap(lambda ib, yb: jnp.zeros((n, D), h.dtype).at[ib.reshape(-1)].add(yb.reshape(-1, D)))(idx, ye)


def setup_inputs(seed: int = 0) -> dict:
    key = jax.random.key(seed)
    keys = iter(jax.random.split(key, 48))

    def nrm(shape, std):
        return jax.random.normal(next(keys), shape, F32) * std

    def unif(shape, lo, hi):
        return jax.random.uniform(next(keys), shape, F32, lo, hi)

    L, D, E = DEPTH, D_MODEL, N_EXPERTS
    return {
        'x': nrm((BATCH, SEQ, D), 1.0),
        'c': nrm((BATCH, D), 1.0),
        'ctx': nrm((BATCH, CTX_LEN, D), 1.0),
        'c_ctx': nrm((D,), 1.0),
        'w_mod': nrm((L, D, 6 * D), 0.5 * D ** -0.5),
        'b_mod': nrm((L, 6 * D), 0.02),
        'norm_pre': 1.0 + nrm((L, 2, D), 0.02),
        'norm_post': 1.0 + nrm((L, 2, D), 0.02),
        'w_in': nrm((L, D, N_IN), D ** -0.5),
        'q_norm': 1.0 + nrm((L, HEAD_DIM), 0.02),
        'k_norm': 1.0 + nrm((L, HEAD_DIM), 0.02),
        'w_attn_o': nrm((L, ATTN_W, D), ATTN_W ** -0.5),
        'w_pool_group': nrm((L, POOL_GROUPS, POOL_GW, POOL_GW), POOL_GW ** -0.5),
        'pool_scale': 1.0 + nrm((L, POOL_W), 0.1),
        'w_pool_o': nrm((L, POOL_W, D), POOL_W ** -0.5),
        'rwkv_mu': unif((L, N_SHIFT), 0.0, 1.0),
        'rwkv_w0': unif((L, N_DIR, RWKV_W), -5.0, -0.5),
        'rwkv_w2': nrm((L, N_DIR, DECAY_LORA, RWKV_W), 0.1 * DECAY_LORA ** -0.5),
        'rwkv_a0': nrm((L, N_DIR, RWKV_W), 0.5),
        'rwkv_a2': nrm((L, N_DIR, AAA_LORA, RWKV_W), 0.5 * AAA_LORA ** -0.5),
        'rwkv_g2': nrm((L, GATE_LORA, RWKV_W), GATE_LORA ** -0.5),
        'rwkv_k_k': 1.0 + nrm((L, RWKV_W), 0.1),
        'rwkv_k_a': 1.0 + nrm((L, RWKV_W), 0.1),
        'rwkv_r_k': nrm((L, RWKV_HEADS, RWKV_HEAD), 0.1),
        'rwkv_ln_w': 1.0 + nrm((L, RWKV_W), 0.02),
        'rwkv_ln_b': nrm((L, RWKV_W), 0.02),
        'w_rwkv_o': nrm((L, RWKV_W, D), RWKV_W ** -0.5),
        'w_out': nrm((L, D, D), D ** -0.5),
        'w_router': nrm((L, D, E), D ** -0.5),
        'w_exp_gate': nrm((L, E, D, EXPERT_FF), D ** -0.5),
        'w_exp_up': nrm((L, E, D, EXPERT_FF), D ** -0.5),
        'w_exp_down': nrm((L, E, EXPERT_FF, D), EXPERT_FF ** -0.5),
    }


def reference(x, c, ctx, c_ctx, w_mod, b_mod, norm_pre, norm_post, w_in, q_norm, k_norm, w_attn_o,
              w_pool_group, pool_scale, w_pool_o, rwkv_mu, rwkv_w0, rwkv_w2, rwkv_a0, rwkv_a2, rwkv_g2,
              rwkv_k_k, rwkv_k_a, rwkv_r_k, rwkv_ln_w, rwkv_ln_b, w_rwkv_o, w_out, w_router,
              w_exp_gate, w_exp_up, w_exp_down):
    B, n_lat, _ = x.shape
    n_ctx = ctx.shape[1]
    cos, sin = axial_rope_tables(n_lat)
    for l in range(DEPTH):
        keep_ctx = l < DEPTH - 1
        m_lat = (jax.nn.silu(c) @ w_mod[l] + b_mod[l]).reshape(B, 1, 6, D_MODEL)
        m_ctx = (jax.nn.silu(c_ctx) @ w_mod[l] + b_mod[l]).reshape(1, 1, 6, D_MODEL)
        h = jnp.concatenate([
            modulated_norm(ctx, norm_pre[l, 0], m_ctx[:, :, 0], m_ctx[:, :, 1]),
            modulated_norm(x, norm_pre[l, 0], m_lat[:, :, 0], m_lat[:, :, 1])], axis=1)
        p = h @ w_in[l]
        mix = token_mixing(p, n_ctx, cos, sin, keep_ctx, q_norm[l], k_norm[l], w_attn_o[l], w_pool_group[l],
                           pool_scale[l], w_pool_o[l], rwkv_mu[l], rwkv_w0[l], rwkv_w2[l], rwkv_a0[l],
                           rwkv_a2[l], rwkv_g2[l], rwkv_k_k[l], rwkv_k_a[l], rwkv_r_k[l], rwkv_ln_w[l],
                           rwkv_ln_b[l], w_rwkv_o[l], w_out[l])
        x = x + m_lat[:, :, 2] * rms_norm(mix[:, mix.shape[1] - n_lat:], norm_post[l, 0])
        f_lat = expert_choice_ffn(modulated_norm(x, norm_pre[l, 1], m_lat[:, :, 3], m_lat[:, :, 4]),
                                  w_router[l], w_exp_gate[l], w_exp_up[l], w_exp_down[l])
        x = x + m_lat[:, :, 5] * rms_norm(f_lat, norm_post[l, 1])
        if keep_ctx:
            ctx = ctx + m_ctx[:, :, 2] * rms_norm(mix[:, :n_ctx], norm_post[l, 0])
            f_ctx = expert_choice_ffn(modulated_norm(ctx, norm_pre[l, 1], m_ctx[:, :, 3], m_ctx[:, :, 4]),
                                      w_router[l], w_exp_gate[l], w_exp_up[l], w_exp_down[l])
            ctx = ctx + m_ctx[:, :, 5] * rms_norm(f_ctx, norm_post[l, 1])
    return x
```

```cpp
#include <hip/hip_runtime.h>
#include <stdint.h>
#include <stdio.h>

#ifndef N_LAUNCH_MODE
#define N_LAUNCH_MODE 1
#endif
#ifndef NAIVE_GEMM
#define NAIVE_GEMM 0
#endif
#ifndef NAIVE_ATTN
#define NAIVE_ATTN 0
#endif

#define LAS __attribute__((address_space(3)))
#define GAS __attribute__((address_space(1)))
typedef unsigned short bf16_t;
typedef short bf16x8 __attribute__((ext_vector_type(8)));
typedef short s16x4 __attribute__((ext_vector_type(4)));
typedef float f32x4 __attribute__((ext_vector_type(4)));
typedef float f32x2 __attribute__((ext_vector_type(2)));
typedef float f32x16 __attribute__((ext_vector_type(16)));
typedef unsigned u32x4 __attribute__((ext_vector_type(4)));
typedef unsigned u32x2 __attribute__((ext_vector_type(2)));

constexpr int D = 2048, NBATCH = 4, SEQ = 4096, CTXL = 256, TS = SEQ + CTXL, R = NBATCH * TS;
constexpr int DEPTH = 2, GRIDW = 64;
constexpr int NQH = 8, NKVH = 2, HDIM = 128;
constexpr int COL_K = 1024, COL_V = 1280, COL_POOL = 1536, COL_R = 2560, COL_GATE = 6208, N_IN = 12352, NSHIFT = 3648;
constexpr int PA_W = 6400, PG_W = 6144, NP_TILES = 49;
constexpr int RWH = 16, RHD = 64, LA_W = 576;
constexpr int NE = 16, FF = 1024, CAP_L = 512, CAP_C = 32, ESLOTS = 2304, NSLOT = NE * ESLOTS;
constexpr float NORM_EPS = 1e-6f, GN_EPS = 64e-5f;
constexpr int NWAVES = 8, NTHR = 512;

constexpr size_t al256(size_t x) { return (x + 255) & ~(size_t)255; }
constexpr size_t WS_CTL = 0, CTL_BYTES = 1u << 20;
constexpr size_t WS_MOD = WS_CTL + CTL_BYTES;
constexpr size_t WS_WB = al256(WS_MOD + (size_t)2 * 5 * 12288 * 4);
constexpr size_t WB_WIN = 0;
constexpr size_t WB_WA = WB_WIN + (size_t)12544 * 2048 * 2;
constexpr size_t WB_WP = WB_WA + (size_t)2048 * 1024 * 2;
constexpr size_t WB_WR = WB_WP + (size_t)2048 * 1024 * 2;
constexpr size_t WB_WOUT = WB_WR + (size_t)2048 * 1024 * 2;
constexpr size_t WB_WPG = WB_WOUT + (size_t)2048 * 2048 * 2;
constexpr size_t WB_W2 = WB_WPG + (size_t)4 * 256 * 256 * 2;
constexpr size_t WB_A2 = WB_W2 + (size_t)2 * 1024 * 64 * 2;
constexpr size_t WB_G2 = WB_A2 + (size_t)2 * 1024 * 64 * 2;
constexpr size_t WB_BYTES = al256(WB_G2 + (size_t)1024 * 320 * 2);
constexpr size_t WS_XS = al256(WS_WB + 2 * WB_BYTES);
constexpr size_t WS_H = WS_XS + (size_t)R * D * 2;
constexpr size_t WS_G = WS_H, WS_PL = WS_H + (size_t)R * 1024 * 2;
constexpr size_t WS_AFF = WS_H + (size_t)R * D * 2;
constexpr size_t WS_TOKSLOT = WS_AFF + (size_t)R * 16 * 4;
constexpr size_t WS_SLOTROW = WS_TOKSLOT + (size_t)R * 16 * 4;
constexpr size_t WS_BON = al256(WS_SLOTROW + (size_t)NSLOT * 4);
constexpr size_t WS_T = al256(WS_BON + (size_t)2 * R * 16 * 4);
constexpr size_t T_PA = 0;
constexpr size_t T_AT = T_PA, T_PO = T_AT + (size_t)R * 1024 * 2, T_RW = T_PO + (size_t)R * 1024 * 2, T_MG = T_RW + (size_t)R * 1024 * 2;
constexpr size_t T_PG = T_PA + (size_t)R * PA_W * 2;
constexpr size_t T_MX = T_PG;
constexpr size_t T_QB = T_PG + (size_t)R * PG_W * 2;
constexpr size_t T_KB = T_QB + (size_t)R * 1024 * 2, T_VB = T_KB + (size_t)R * 256 * 2;
constexpr size_t T_WD = T_VB + (size_t)R * 256 * 2;
constexpr size_t T_KD = T_WD + (size_t)2 * R * 1024 * 4;
constexpr size_t T_BD = T_KD + (size_t)2 * R * 1024 * 2;
constexpr size_t T_KK = T_BD + (size_t)2 * R * 1024 * 2;
constexpr size_t T_RR = T_KK + (size_t)R * 1024 * 2, T_VV = T_RR + (size_t)R * 1024 * 2, T_KS = T_VV + (size_t)R * 1024 * 2;
constexpr size_t T_LA = T_KS + (size_t)R * 1024 * 2;
constexpr size_t T_END_MIX = al256(T_LA + (size_t)R * LA_W * 2);
constexpr size_t T_XG = 0, T_HID = T_XG + (size_t)NSLOT * D * 2, T_Y = T_HID + (size_t)NSLOT * FF * 2;
static_assert(T_HID + (size_t)NSLOT * FF * 2 + (size_t)NSLOT * D * 2 <= T_PG + (size_t)R * PG_W * 2, "XG | HID | Y end before the expert weight copies");
constexpr size_t T_WGU = T_QB;
constexpr size_t T_WDN = T_WGU + (size_t)NE * 2048 * 2048 * 2;
constexpr size_t T_END_MOE = T_WDN + (size_t)NE * 2048 * 1024 * 2;
static_assert(T_WDN == T_WGU + (size_t)NE * 2048 * 2048 * 2, "down copy follows the gate/up copy");
constexpr size_t WS_MOE1 = WS_T + (T_END_MIX > T_END_MOE ? T_END_MIX : T_END_MOE);
constexpr size_t MOE_WGU_BYTES = (size_t)NE * 2048 * 2048 * 2, MOE_W_BYTES = MOE_WGU_BYTES + (size_t)NE * 2048 * 1024 * 2;
constexpr size_t WS_END = WS_MOE1 + MOE_W_BYTES;
static_assert(T_MG + (size_t)R * D * 2 <= T_PG, "AT|PO|RW|MG fit in PA");
constexpr int CW_TMO = 0, CW_BAR = 4096;

__device__ __forceinline__ float bf2f(unsigned b) { return __uint_as_float(b << 16); }
__device__ __forceinline__ float bflo(unsigned w) { return __uint_as_float(w << 16); }
__device__ __forceinline__ float bfhi(unsigned w) { return __uint_as_float(w & 0xffff0000u); }
typedef __bf16 bf16x2_t __attribute__((ext_vector_type(2)));
__device__ __forceinline__ unsigned pk2(float lo, float hi) { const bf16x2_t v = __builtin_convertvector((f32x2){lo, hi}, bf16x2_t); return __builtin_bit_cast(unsigned, v); }
__device__ __forceinline__ bf16_t f2bf(float f) { return (bf16_t)(pk2(f, 0.f) & 0xffffu); }
__device__ __forceinline__ float wave_sum(float v) {
#pragma unroll
    for (int o = 1; o < 64; o <<= 1) v += __shfl_xor(v, o);
    return v;
}
__device__ __forceinline__ float sigmoidf_(float x) { return __builtin_amdgcn_rcpf(1.0f + __expf(-x)); }
__device__ __forceinline__ float tanhf_(float x) { return 1.0f - 2.0f * __builtin_amdgcn_rcpf(1.0f + __expf(2.0f * x)); }
namespace rk {
__device__ __forceinline__ u32x2 pk4(const f32x4 v) { u32x2 w; w.x = pk2(v[0], v[1]); w.y = pk2(v[2], v[3]); return w; }
__device__ __forceinline__ f32x4 up4(const u32x2 w) { return (f32x4){bflo(w.x), bfhi(w.x), bflo(w.y), bfhi(w.y)}; }
}
#define LDS_WAIT() asm volatile("s_waitcnt lgkmcnt(0)" ::: "memory")
#define VM_WAIT() asm volatile("s_waitcnt vmcnt(0)" ::: "memory")

#define XB_TMO      128
#define XB_XCNT(j)  (256  + 64 * (j))
#define XB_XSUB(j)  (1280 + 64 * (j))
#define XB_XGEN(j)  (2304 + 64 * (j))
#define XB_TOP      3328
#define XB_TOPGEN   3392
#define XCD_BAR_WORDS 3456
#define XB_SPIN_CAP (1u << 22)
__device__ __forceinline__ unsigned xb_ld(unsigned* p)              { return __hip_atomic_load(p, __ATOMIC_RELAXED, __HIP_MEMORY_SCOPE_AGENT); }
__device__ __forceinline__ unsigned xb_add(unsigned* p, unsigned v) { return __hip_atomic_fetch_add(p, v, __ATOMIC_RELAXED, __HIP_MEMORY_SCOPE_AGENT); }
__device__ __forceinline__ unsigned xb_xcc_id() { return (unsigned)__builtin_amdgcn_s_getreg((3 << 11) | 20) & 0xFu; }
#define XB_SPIN(cond, bar) do { unsigned _sp = 0; while (cond) { __builtin_amdgcn_s_sleep(1); \
    if ((++_sp & 255u) == 0u) { if (xb_ld(&(bar)[XB_TMO])) break; if (_sp > XB_SPIN_CAP) { atomicAdd(&(bar)[XB_TMO], 1u); break; } } } } while (0)
struct XcdBarrier { unsigned* bar; unsigned x; volatile LAS unsigned* st; };
__device__ __forceinline__ XcdBarrier xcd_barrier_post(unsigned* bar, volatile LAS unsigned* st) {
    XcdBarrier b; b.bar = bar; b.x = xb_xcc_id(); b.st = st;
    if (threadIdx.x == 0) (void)xb_add(&bar[XB_XCNT(b.x)], 1u);
    return b;
}
__device__ __forceinline__ void xcd_barrier_complete(unsigned* bar, unsigned x, unsigned& nloc, unsigned& nx) {
    const unsigned G = gridDim.x * gridDim.y * gridDim.z;
    unsigned sum, cnt, mine, sp = 0u;
    for (;;) {
        sum = 0u; cnt = 0u; mine = 0u;
#pragma unroll
        for (unsigned j = 0; j < 16; ++j) { const unsigned c = xb_ld(&bar[XB_XCNT(j)]); sum += c; cnt += (c > 0u) ? 1u : 0u; mine = (j == x) ? c : mine; }
        if (sum == G) break;
        __builtin_amdgcn_s_sleep(1);
        if ((++sp & 255u) == 0u) { if (xb_ld(&bar[XB_TMO])) break; if (sp > XB_SPIN_CAP) { atomicAdd(&bar[XB_TMO], 1u); break; } }
    }
    nloc = mine > 0u ? mine : 1u; nx = cnt > 0u ? cnt : 1u;
}
__device__ __forceinline__ void xcd_barrier(const XcdBarrier& b) {
    asm volatile("s_waitcnt vmcnt(0)" ::: "memory");
    __syncthreads();
    if (threadIdx.x == 0) {
        unsigned* bar = b.bar;
        __builtin_amdgcn_s_waitcnt(0);
        unsigned nloc = b.st[0], nx = b.st[1];
        if (nloc == 0u) { xcd_barrier_complete(bar, b.x, nloc, nx); b.st[0] = nloc; b.st[1] = nx; }
        const unsigned old = xb_add(&bar[XB_XSUB(b.x)], 1u);
        const unsigned gen = old / nloc;
        if (old + 1u == (gen + 1u) * nloc) {
            __builtin_amdgcn_fence(__ATOMIC_RELEASE, "agent");
            asm volatile("s_waitcnt vmcnt(0)" ::: "memory");
            const unsigned og = xb_add(&bar[XB_TOP], 1u);
            const unsigned tg = og / nx;
            if (og + 1u == (tg + 1u) * nx) xb_add(&bar[XB_TOPGEN], 1u);
            else XB_SPIN(xb_ld(&bar[XB_TOPGEN]) == tg, bar);
            __builtin_amdgcn_fence(__ATOMIC_ACQUIRE, "agent");
            xb_add(&bar[XB_XGEN(b.x)], 1u);
            asm volatile("s_waitcnt vmcnt(0)" ::: "memory");
        } else {
            XB_SPIN(xb_ld(&bar[XB_XGEN(b.x)]) == gen, bar);
            __builtin_amdgcn_fence(__ATOMIC_ACQUIRE, "agent");
            asm volatile("s_waitcnt vmcnt(0)" ::: "memory");
        }
    }
    __syncthreads();
}

namespace pg8 {
constexpr int BM = 256, BK = 64, HALF = 128, HTB = HALF * BK * 2, STAGE_BYTES = 8 * HTB;
__host__ __device__ __forceinline__ int lds_byte(int r, int c) { const int st = (r >> 4) * 2 + (c >> 5), rr = r & 15, cc = c & 31, ob = rr * 64 + cc * 2; return st * 1024 + (ob ^ (((ob >> 9) & 1) << 5)); }
__host__ __device__ __forceinline__ void stage_rc(int b, int& Rr, int& C) { const int st = b / 1024, sb = b % 1024, swz = sb ^ (((sb >> 9) & 1) << 5); Rr = (st >> 1) * 16 + swz / 64; C = (st & 1) * 32 + (swz % 64) / 2; }
__host__ __device__ __forceinline__ int perm32(int rho) { const int n = rho >> 4, i = rho & 15; return 8 * (i >> 2) + 4 * n + (i & 3); }
struct Unit { const char* A; const char* B; int pm, pn, aux; const int* gidx; };
struct Desc { int K, lda, ldb; };
typedef f32x4 Acc[2][2][4][2];

#if !NAIVE_GEMM
template <class Epi, class Sched>
__device__ __forceinline__ void gemm_phase(LAS unsigned char* lds, const Desc g, const Sched& S, const Epi& E, const int tid) {
    const int wid = __builtin_amdgcn_readfirstlane(tid >> 6), lane = tid & 63, wr = wid >> 2, wc = wid & 3, fr = lane & 15, fq = lane >> 4;
    int K = g.K; asm volatile("" : "+s"(K)); const int nt = K / BK;
    unsigned voffA[2], voffB[2]; int rrA[2], ccA[2];
#pragma unroll
    for (int i = 0; i < 2; ++i) { int Rr, C; stage_rc(tid * 16 + i * 8192, Rr, C); const int Rb = (Rr & ~31) + perm32(Rr & 31); rrA[i] = Rr; ccA[i] = C;
        voffA[i] = (unsigned)(Rr * g.lda + C) * 2u; voffB[i] = (unsigned)(Rb * g.ldb + C) * 2u; }
    constexpr bool GATHER = Sched::GATHER;
    unsigned cO[2][2], nO[2][2];
#define PG8_GOFF(unit, o) do { _Pragma("unroll") for (int _h = 0; _h < 2; ++_h) _Pragma("unroll") for (int _i = 0; _i < 2; ++_i) { unsigned gi_ = (unsigned)(unit).gidx[_h * HALF + rrA[_i]]; gi_ = gi_ < (unsigned)R ? gi_ : (unsigned)(R - 1); \
        (o)[_h][_i] = (gi_ * (unsigned)g.lda + (unsigned)ccA[_i]) * 2u; } } while (0)
#define PG8_ASTAGE(bufoff, gbase, h, usenext) do { if constexpr (GATHER) { unsigned o_[2] = {(usenext) ? nO[h][0] : cO[h][0], (usenext) ? nO[h][1] : cO[h][1]}; PG8_STAGE(bufoff, gbase, o_); } \
        else { PG8_STAGE(bufoff, (gbase) + ((h) ? hstepA : (size_t)0), voffA); } } while (0)
    const size_t kstep = (size_t)(BK * 2);
    const size_t hstepA = (size_t)HALF * g.lda * 2, hstepB = (size_t)HALF * g.ldb * 2;
    const unsigned ldsw = (unsigned)wid * 1024u;
    const int aoff = lds_byte(wr * 64 + fr, fq * 8), boff = lds_byte(wc * 32 + fr, fq * 8);
#define PG8_SA(b, h) (((b) * 2 + (h)) * HTB)
#define PG8_SB(b, h) ((4 + (b) * 2 + (h)) * HTB)
#define PG8_STAGE(bufoff, gbase, voff) do { _Pragma("unroll") for (int _i = 0; _i < 2; ++_i) \
        __builtin_amdgcn_global_load_lds((const unsigned*)((const char*)(gbase) + (voff)[_i]), (LAS unsigned*)(lds + (bufoff) + ldsw + _i * 8192), 16, 0, 0); } while (0)
#define PG8_LDA(dst, b, h) do { _Pragma("unroll") for (int m = 0; m < 4; ++m) _Pragma("unroll") for (int k = 0; k < 2; ++k) dst[m][k] = *(const LAS bf16x8*)(lds + PG8_SA(b, h) + aoff + m * 2048 + k * 1024); } while (0)
#define PG8_LDB(dst, b, h) do { _Pragma("unroll") for (int n = 0; n < 2; ++n) _Pragma("unroll") for (int k = 0; k < 2; ++k) dst[n][k] = *(const LAS bf16x8*)(lds + PG8_SB(b, h) + boff + n * 2048 + k * 1024); } while (0)
#define PG8_MMA(ai, bj, At, Bt) do { __builtin_amdgcn_s_setprio(1); _Pragma("unroll") for (int m = 0; m < 4; ++m) _Pragma("unroll") for (int n = 0; n < 2; ++n) _Pragma("unroll") for (int k = 0; k < 2; ++k) \
        acc[ai][bj][m][n] = __builtin_amdgcn_mfma_f32_16x16x32_bf16(Bt[n][k], At[m][k], acc[ai][bj][m][n], 0, 0, 0); __builtin_amdgcn_s_setprio(0); } while (0)
#define PG8_WAIT_V(n) asm volatile("s_waitcnt vmcnt(" #n ")" ::: "memory")
#define PG8_WAIT_L(n) asm volatile("s_waitcnt lgkmcnt(" #n ")" ::: "memory")
#define PG8_BAR __builtin_amdgcn_s_barrier()
#define PG8_SCHED __builtin_amdgcn_sched_barrier(0)
    Unit cur, nxt; int ui = 0;
    if (!S.next(0, cur)) return;
    Acc acc;
#pragma unroll
    for (int a = 0; a < 2; ++a)
#pragma unroll
        for (int b = 0; b < 2; ++b)
#pragma unroll
            for (int m = 0; m < 4; ++m)
#pragma unroll
                for (int n = 0; n < 2; ++n) acc[a][b][m][n] = (f32x4){0.f, 0.f, 0.f, 0.f};
    bf16x8 At[4][2], B0[2][2], B1[2][2];
    const char* cA = cur.A; const char* cB = cur.B;
    if constexpr (GATHER) { PG8_GOFF(cur, cO); }
    PG8_STAGE(PG8_SB(0, 0), cB, voffB); PG8_ASTAGE(PG8_SA(0, 0), cA, 0, false); PG8_STAGE(PG8_SB(0, 1), cB + hstepB, voffB); PG8_ASTAGE(PG8_SA(0, 1), cA, 1, false);
    if (wr == 1) PG8_BAR;
    PG8_WAIT_V(4); PG8_BAR;
    PG8_STAGE(PG8_SB(1, 0), cB + kstep, voffB); PG8_ASTAGE(PG8_SA(1, 0), cA + kstep, 0, false); PG8_STAGE(PG8_SB(1, 1), cB + hstepB + kstep, voffB);
    PG8_WAIT_V(6); PG8_BAR;
    for (;;) {
        const bool has_next = S.next(ui + 1, nxt);
        const char* nA = has_next ? nxt.A : cA; const char* nB = has_next ? nxt.B : cB;
        if constexpr (GATHER) { if (has_next) { PG8_GOFF(nxt, nO); } else {
#pragma unroll
            for (int _h = 0; _h < 2; ++_h) { nO[_h][0] = cO[_h][0]; nO[_h][1] = cO[_h][1]; } } }
        for (int t = 0; t < nt; t += 2) {
            const bool last = (t == nt - 2);
            const char* a1 = cA + (size_t)(t + 1) * kstep;
            const char* a2 = last ? nA : cA + (size_t)(t + 2) * kstep; const char* b2 = last ? nB : cB + (size_t)(t + 2) * kstep;
            const char* a3 = a2 + kstep; const char* b3 = b2 + kstep;
            PG8_LDB(B0, 0, 0); PG8_SCHED; PG8_LDA(At, 0, 0); PG8_ASTAGE(PG8_SA(1, 1), a1, 1, false);
            PG8_WAIT_L(8); PG8_BAR; PG8_WAIT_L(0); PG8_MMA(0, 0, At, B0); PG8_BAR; PG8_SCHED;
            PG8_LDB(B1, 0, 1); PG8_STAGE(PG8_SB(0, 0), b2, voffB);
            PG8_BAR; PG8_WAIT_L(0); PG8_MMA(0, 1, At, B1); PG8_BAR;
            PG8_LDA(At, 0, 1); PG8_ASTAGE(PG8_SA(0, 0), a2, 0, last);
            PG8_BAR; PG8_WAIT_L(0); PG8_MMA(1, 0, At, B0); PG8_BAR; PG8_SCHED;
            PG8_STAGE(PG8_SB(0, 1), b2 + hstepB, voffB);
            PG8_WAIT_V(6); PG8_BAR; PG8_MMA(1, 1, At, B1); PG8_BAR;
            PG8_LDB(B0, 1, 0); PG8_SCHED; PG8_LDA(At, 1, 0); PG8_ASTAGE(PG8_SA(0, 1), a2, 1, last);
            PG8_WAIT_L(8); PG8_BAR; PG8_WAIT_L(0); PG8_MMA(0, 0, At, B0); PG8_BAR; PG8_SCHED;
            PG8_LDB(B1, 1, 1); PG8_STAGE(PG8_SB(1, 0), b3, voffB);
            PG8_BAR; PG8_WAIT_L(0); PG8_MMA(0, 1, At, B1); PG8_BAR;
            PG8_LDA(At, 1, 1); PG8_ASTAGE(PG8_SA(1, 0), a3, 0, last);
            PG8_BAR; PG8_WAIT_L(0); PG8_MMA(1, 0, At, B0); PG8_BAR; PG8_SCHED;
            PG8_STAGE(PG8_SB(1, 1), b3 + hstepB, voffB);
            PG8_WAIT_V(6); PG8_BAR; PG8_MMA(1, 1, At, B1); PG8_BAR;
        }
        const bool keep = E(acc, cur, wr, wc, fr, fq);
        if (!has_next) break;
        if (!keep) {
#pragma unroll
            for (int a = 0; a < 2; ++a)
#pragma unroll
                for (int b = 0; b < 2; ++b)
#pragma unroll
                    for (int m = 0; m < 4; ++m)
#pragma unroll
                        for (int n = 0; n < 2; ++n) acc[a][b][m][n] = (f32x4){0.f, 0.f, 0.f, 0.f};
        }
        cur = nxt; cA = nA; cB = nB; ++ui;
        if constexpr (GATHER) {
#pragma unroll
            for (int _h = 0; _h < 2; ++_h) { cO[_h][0] = nO[_h][0]; cO[_h][1] = nO[_h][1]; } }
    }
    PG8_WAIT_V(0);
    if (wr == 0) PG8_BAR;
    PG8_BAR;
#undef PG8_GOFF
#undef PG8_ASTAGE
#undef PG8_SA
#undef PG8_SB
#undef PG8_STAGE
#undef PG8_LDA
#undef PG8_LDB
#undef PG8_MMA
#undef PG8_WAIT_V
#undef PG8_WAIT_L
#undef PG8_BAR
#undef PG8_SCHED
}
#else
template <class Epi, class Sched>
__device__ __forceinline__ void gemm_phase(LAS unsigned char* lds, const Desc g, const Sched& S, const Epi& E, const int tid) {
    const int wid = tid >> 6, lane = tid & 63, wr = wid >> 2, wc = wid & 3, fr = lane & 15, fq = lane >> 4;
    Unit u; Acc acc;
#pragma unroll
    for (int a = 0; a < 2; ++a)
#pragma unroll
        for (int b = 0; b < 2; ++b)
#pragma unroll
            for (int m = 0; m < 4; ++m)
#pragma unroll
                for (int n = 0; n < 2; ++n) acc[a][b][m][n] = (f32x4){0.f, 0.f, 0.f, 0.f};
    for (int i = 0; S.next(i, u); ++i) {
        const bf16_t* A = (const bf16_t*)u.A; const bf16_t* B = (const bf16_t*)u.B;
        for (int k8 = 0; k8 < g.K / 8; ++k8) {
            float af[2][4][8];
#pragma unroll
            for (int ai = 0; ai < 2; ++ai)
#pragma unroll
                for (int m = 0; m < 4; ++m) { const u32x4 w = *(const u32x4*)(A + (size_t)(128 * ai + 64 * wr + 16 * m + fr) * g.lda + k8 * 8);
                    af[ai][m][0] = bflo(w.x); af[ai][m][1] = bfhi(w.x); af[ai][m][2] = bflo(w.y); af[ai][m][3] = bfhi(w.y); af[ai][m][4] = bflo(w.z); af[ai][m][5] = bfhi(w.z); af[ai][m][6] = bflo(w.w); af[ai][m][7] = bfhi(w.w); }
#pragma unroll
            for (int bj = 0; bj < 2; ++bj)
#pragma unroll
                for (int n = 0; n < 2; ++n)
#pragma unroll
                    for (int j = 0; j < 4; ++j) { const u32x4 w = *(const u32x4*)(B + (size_t)(128 * bj + 32 * wc + 8 * fq + 4 * n + j) * g.ldb + k8 * 8);
                        float bf[8]; bf[0] = bflo(w.x); bf[1] = bfhi(w.x); bf[2] = bflo(w.y); bf[3] = bfhi(w.y); bf[4] = bflo(w.z); bf[5] = bfhi(w.z); bf[6] = bflo(w.w); bf[7] = bfhi(w.w);
#pragma unroll
                        for (int ai = 0; ai < 2; ++ai)
#pragma unroll
                            for (int m = 0; m < 4; ++m) { float s = acc[ai][bj][m][n][j];
#pragma unroll
                                for (int q = 0; q < 8; ++q) s += af[ai][m][q] * bf[q];
                                acc[ai][bj][m][n][j] = s; } }
        }
        const bool keep = E(acc, u, wr, wc, fr, fq);
        if (!keep) {
#pragma unroll
            for (int a = 0; a < 2; ++a)
#pragma unroll
                for (int b = 0; b < 2; ++b)
#pragma unroll
                    for (int m = 0; m < 4; ++m)
#pragma unroll
                        for (int n = 0; n < 2; ++n) acc[a][b][m][n] = (f32x4){0.f, 0.f, 0.f, 0.f};
        }
    }
}
#endif

__device__ __forceinline__ void tile_of(int L, int nM, int nN, int& pm, int& pn) {
    const int nwg = nM * nN; int wgid = L; { const int q = nwg / 8, r = nwg % 8, xcd = wgid % 8, off = wgid / 8; wgid = (xcd < r ? xcd * (q + 1) : r * (q + 1) + (xcd - r) * q) + off; }
    const int nig = 8 * nN, gid = wgid / nig, fm = gid * 8, gsz = (nM - fm) < 8 ? (nM - fm) : 8;
    pm = fm + ((wgid % nig) % gsz); pn = (wgid % nig) / gsz;
}
__device__ __forceinline__ void st8(bf16_t* p, const f32x4 v0, const f32x4 v1) { u32x4 w; w.x = pk2(v0[0], v0[1]); w.y = pk2(v0[2], v0[3]); w.z = pk2(v1[0], v1[1]); w.w = pk2(v1[2], v1[3]); *(u32x4*)p = w; }
}

namespace att {
constexpr int DH = 128, NW = 8, QBLK = 32, KVBLK = 64, LDQ = 1024, LDK = 256, LDO = 1024;
constexpr float SCALE = 0.088388347648318440f;
constexpr float THR = 8.f;
constexpr size_t SHM_V = KVBLK * DH * 2, SHM_K = KVBLK * DH * 2, SHM_ATTN = 2 * SHM_V + 2 * SHM_K + NW * 64 * 4;
#if !NAIVE_ATTN
#define KSWZ(row, colB) ((row) * 256 + ((colB) ^ (((row) & 7) << 4)))
#define SBAR() __builtin_amdgcn_sched_barrier(0)
__device__ __forceinline__ int crow(int r, int hi) { return (r & 3) + 8 * (r >> 2) + 4 * hi; }
__device__ __forceinline__ void partialSM(f32x16& p0, f32x16& p1, float& m_reg, float& mn, float& alpha) {
  constexpr float C = SCALE * 1.4426950408889634f;
  float pmax = p0[0]; for (int r = 1; r < 16; ++r) pmax = fmaxf(pmax, p0[r]); for (int r = 0; r < 16; ++r) pmax = fmaxf(pmax, p1[r]);
  { auto rr = __builtin_amdgcn_permlane32_swap(__float_as_uint(pmax), __float_as_uint(pmax), false, false);
    pmax = fmaxf(__uint_as_float(rr[0]), __uint_as_float(rr[1])); }
  if (__builtin_expect(__all(pmax - m_reg <= THR / SCALE), 1)) { mn = m_reg; alpha = 1.f; }
  else { mn = fmaxf(m_reg, pmax); alpha = __builtin_amdgcn_exp2f((m_reg - mn) * C); m_reg = mn; }
  float mnC = -mn * C;
  for (int r = 0; r < 16; ++r) p0[r] = fmaf(p0[r], C, mnC); for (int r = 0; r < 16; ++r) p1[r] = fmaf(p1[r], C, mnC);
  for (int r = 0; r < 16; ++r) p0[r] = __builtin_amdgcn_exp2f(p0[r]);
}
__device__ __forceinline__ void finishSM(f32x16& p0, f32x16& p1, float alpha, float& l_reg, bf16x8& pa0, bf16x8& pa1, bf16x8& pa2, bf16x8& pa3) {
  for (int r = 0; r < 16; ++r) p1[r] = __builtin_amdgcn_exp2f(p1[r]);
  float ps = 0; for (int r = 0; r < 16; ++r) ps += p0[r]; for (int r = 0; r < 16; ++r) ps += p1[r];
  { auto rr = __builtin_amdgcn_permlane32_swap(__float_as_uint(ps), __float_as_uint(ps), false, false);
    ps = __uint_as_float(rr[0]) + __uint_as_float(rr[1]); }
  l_reg = l_reg * alpha + ps;
#define PK4(P, BASE, OUT) do { unsigned a0 = pk2(P[BASE + 0], P[BASE + 1]), a1 = pk2(P[BASE + 2], P[BASE + 3]);   \
    unsigned b0 = pk2(P[BASE + 4], P[BASE + 5]), b1 = pk2(P[BASE + 6], P[BASE + 7]);                              \
    auto r0 = __builtin_amdgcn_permlane32_swap(a0, b0, false, false); auto r1 = __builtin_amdgcn_permlane32_swap(a1, b1, false, false); \
    u32x4 w = {r0[0], r1[0], r0[1], r1[1]}; OUT = *reinterpret_cast<bf16x8*>(&w); } while (0)
  PK4(p0, 0, pa0); PK4(p0, 8, pa1); PK4(p1, 0, pa2); PK4(p1, 8, pa3);
#undef PK4
}
__device__ __forceinline__ void qkt(f32x16& p0, f32x16& p1, const bf16_t* Ks, const bf16x8* qr, int r32, int hi) {
  p0 = f32x16{}; p1 = f32x16{};
  for (int d0 = 0; d0 < 8; ++d0) { int cb = (d0 * 16 + hi * 8) * 2;
    bf16x8 b0 = *reinterpret_cast<const bf16x8*>((const char*)Ks + KSWZ(r32, cb));
    bf16x8 b1 = *reinterpret_cast<const bf16x8*>((const char*)Ks + KSWZ(32 + r32, cb));
    p0 = __builtin_amdgcn_mfma_f32_32x32x16_bf16(b0, qr[d0], p0, 0, 0, 0);
    p1 = __builtin_amdgcn_mfma_f32_32x32x16_bf16(b1, qr[d0], p1, 0, 0, 0); }
}
__device__ __forceinline__ int v_st(int k, int c) { const int kk = (k & ~0xC) | ((k & 4) << 1) | ((k & 8) >> 1); return ((kk >> 3) * 4 + (c >> 5)) * 512 + ((kk & 7) * 32 + (c & 31)) * 2; }
__device__ __forceinline__ int v_rd_base(int lane) { return ((lane & 3) << 3) | (((lane >> 2) & 3) << 6) | (((lane >> 4) & 1) << 5) | (((lane >> 5) & 1) << 8); }
constexpr int v_rd_off(int d0, int ks, int half) { return d0 * 512 + ks * 4096 + half * 2048; }
template <int OFF> __device__ __forceinline__ s16x4 tr_read(int vb) {
  s16x4 r; asm volatile("ds_read_b64_tr_b16 %0, %1 offset:%2" : "=&v"(r) : "v"(vb), "i"(OFF) : "memory"); return r;
}
template <int D0> __device__ __forceinline__ void pv_one(f32x16& od, int vb, bf16x8 pa0, bf16x8 pa1, bf16x8 pa2, bf16x8 pa3) {
  const s16x4 l0 = tr_read<v_rd_off(D0, 0, 0)>(vb), h0 = tr_read<v_rd_off(D0, 0, 1)>(vb), l1 = tr_read<v_rd_off(D0, 1, 0)>(vb), h1 = tr_read<v_rd_off(D0, 1, 1)>(vb);
  const s16x4 l2 = tr_read<v_rd_off(D0, 2, 0)>(vb), h2 = tr_read<v_rd_off(D0, 2, 1)>(vb), l3 = tr_read<v_rd_off(D0, 3, 0)>(vb), h3 = tr_read<v_rd_off(D0, 3, 1)>(vb);
  asm volatile("s_waitcnt lgkmcnt(0)" ::: "memory"); SBAR();
#define PK(L, H) (bf16x8){L[0], L[1], L[2], L[3], H[0], H[1], H[2], H[3]}
  od = __builtin_amdgcn_mfma_f32_32x32x16_bf16(pa0, PK(l0, h0), od, 0, 0, 0);
  od = __builtin_amdgcn_mfma_f32_32x32x16_bf16(pa1, PK(l1, h1), od, 0, 0, 0);
  od = __builtin_amdgcn_mfma_f32_32x32x16_bf16(pa2, PK(l2, h2), od, 0, 0, 0);
  od = __builtin_amdgcn_mfma_f32_32x32x16_bf16(pa3, PK(l3, h3), od, 0, 0, 0);
#undef PK
}
__device__ __forceinline__ void pv_d0(f32x16* o, int vb, bf16x8 pa0, bf16x8 pa1, bf16x8 pa2, bf16x8 pa3) {
  pv_one<0>(o[0], vb, pa0, pa1, pa2, pa3); pv_one<1>(o[1], vb, pa0, pa1, pa2, pa3); pv_one<2>(o[2], vb, pa0, pa1, pa2, pa3); pv_one<3>(o[3], vb, pa0, pa1, pa2, pa3);
}
__device__ __forceinline__ void attn_unit(const bf16_t* __restrict__ Qb, const bf16_t* __restrict__ Kh, const bf16_t* __restrict__ Vh, bf16_t* __restrict__ Ob, int seq, char* lds, const int tid) {
  const int wid = tid >> 6, lane = tid & 63, r32 = lane & 31, hi = lane >> 5;
  bf16_t* V_lds = (bf16_t*)lds; bf16_t* K_lds = (bf16_t*)(lds + 2 * SHM_V);
  float* ws = (float*)(lds + 2 * SHM_V + 2 * SHM_K) + wid * 64; float* li_l = ws; float* al_l = ws + 32;
  float m_reg = -1e30f, l_reg = 0; f32x16 o[4] = {}; bf16x8 qr[8];
  const bf16_t* Qw = Qb + (long)(wid * QBLK + r32) * LDQ + hi * 8;
#pragma unroll
  for (int d0 = 0; d0 < 8; ++d0) qr[d0] = *reinterpret_cast<const bf16x8*>(Qw + d0 * 16);
  const int sr = tid >> 4, sc = (tid & 15) * 8, vst0 = v_st(sr, sc), vst1 = v_st(32 + sr, sc);
  const int vb0 = (int)(uintptr_t)V_lds + v_rd_base(lane);
  struct { bf16x8 vs0, vs1, ks0, ks1; } sr_[2];
  const unsigned voff0 = (unsigned)(sr * LDK + sc) * 2u, voff1 = voff0 + 32u * LDK * 2u;
#define SLOAD(i, k0) do { const char* vb_ = (const char*)Vh + (size_t)(k0) * (LDK * 2); const char* kb_ = (const char*)Kh + (size_t)(k0) * (LDK * 2); \
    sr_[i].vs0 = *(const bf16x8*)(vb_ + voff0); sr_[i].vs1 = *(const bf16x8*)(vb_ + voff1); sr_[i].ks0 = *(const bf16x8*)(kb_ + voff0); sr_[i].ks1 = *(const bf16x8*)(kb_ + voff1); } while (0)
#define SWRITE(b, i) do { *(bf16x8*)((char*)V_lds + (b) * SHM_V + vst0) = sr_[i].vs0;          \
    *(bf16x8*)((char*)V_lds + (b) * SHM_V + vst1) = sr_[i].vs1; int kc = sc * 2;               \
    *(bf16x8*)((char*)K_lds + (b) * SHM_K + KSWZ(sr, kc)) = sr_[i].ks0;                       \
    *(bf16x8*)((char*)K_lds + (b) * SHM_K + KSWZ(32 + sr, kc)) = sr_[i].ks1; } while (0)
#define SWAIT() asm volatile("s_waitcnt vmcnt(4)" ::: "memory")
#define RESC(a) do { if (__any((a) < 1.f)) { if (hi == 0) al_l[r32] = (a); asm volatile("s_waitcnt lgkmcnt(0)" ::: "memory"); \
    for (int d = 0; d < 4; ++d) for (int r = 0; r < 16; ++r) o[d][r] *= al_l[crow(r, hi)]; } } while (0)
  f32x16 pA0, pA1, pB0, pB1; float mnA, mnB, alA, alB; bf16x8 pa0, pa1, pa2, pa3; const int NT = seq / KVBLK;
  constexpr int SE = 0, SO = 1;
  SLOAD(SE, 0); asm volatile("s_waitcnt vmcnt(0)" ::: "memory"); SWRITE(0, SE); __syncthreads();
  qkt(pA0, pA1, K_lds, qr, r32, hi); partialSM(pA0, pA1, m_reg, mnA, alA);
  SLOAD(SO, KVBLK); if (2 < NT) SLOAD(SE, 2 * KVBLK);
  SWAIT(); SWRITE(1, SO); __syncthreads();
  for (int j = 1; j + 1 < NT; j += 2) {
    SBAR(); qkt(pB0, pB1, (bf16_t*)((char*)K_lds + SHM_K), qr, r32, hi);
    finishSM(pA0, pA1, alA, l_reg, pa0, pa1, pa2, pa3); SBAR();
    SLOAD(SO, (j + 2) * KVBLK); SBAR();
    pv_d0(o, vb0, pa0, pa1, pa2, pa3); partialSM(pB0, pB1, m_reg, mnB, alB);
    __syncthreads(); SWAIT(); SWRITE(0, SE);
    RESC(alB); __syncthreads();
    SBAR(); qkt(pA0, pA1, K_lds, qr, r32, hi);
    finishSM(pB0, pB1, alB, l_reg, pa0, pa1, pa2, pa3); SBAR();
    if (j + 3 < NT) SLOAD(SE, (j + 3) * KVBLK); SBAR();
    pv_d0(o, vb0 + (int)SHM_V, pa0, pa1, pa2, pa3); partialSM(pA0, pA1, m_reg, mnA, alA);
    __syncthreads(); SWAIT(); SWRITE(1, SO);
    RESC(alA); __syncthreads();
  }
  SBAR(); qkt(pB0, pB1, (bf16_t*)((char*)K_lds + SHM_K), qr, r32, hi);
  finishSM(pA0, pA1, alA, l_reg, pa0, pa1, pa2, pa3); SBAR();
  pv_d0(o, vb0, pa0, pa1, pa2, pa3); partialSM(pB0, pB1, m_reg, mnB, alB);
  __syncthreads(); RESC(alB);
  finishSM(pB0, pB1, alB, l_reg, pa0, pa1, pa2, pa3); SBAR();
  pv_d0(o, vb0 + (int)SHM_V, pa0, pa1, pa2, pa3);
  if (hi == 0) li_l[r32] = l_reg; asm volatile("s_waitcnt lgkmcnt(0)" ::: "memory");
  float rli[16];
#pragma unroll
  for (int r = 0; r < 16; ++r) rli[r] = __builtin_amdgcn_rcpf(li_l[crow(r, hi)]);
  bf16_t* Ow = Ob + (long)(wid * QBLK) * LDO;
#pragma unroll
  for (int r = 0; r < 16; ++r) { int orow = crow(r, hi);
    for (int d0 = 0; d0 < 4; ++d0) Ow[(long)orow * LDO + d0 * 32 + r32] = f2bf(o[d0][r] * rli[r]); }
  __syncthreads();
#undef SLOAD
#undef SWRITE
#undef SWAIT
#undef RESC
}
#else
__device__ __forceinline__ void attn_unit(const bf16_t* __restrict__ Qb, const bf16_t* __restrict__ Kh, const bf16_t* __restrict__ Vh, bf16_t* __restrict__ Ob, int seq, char* lds, const int tid) {
  const int qi = tid >> 1, hf = tid & 1;
  float q[64], o[64];
#pragma unroll
  for (int i = 0; i < 64; ++i) { q[i] = bf2f(Qb[(long)qi * LDQ + hf * 64 + i]); o[i] = 0.f; }
  float m = -1e30f, l = 0.f;
  for (int kx = 0; kx < seq; ++kx) {
    const u32x4* kp = (const u32x4*)(Kh + (long)kx * LDK + hf * 64); float s = 0.f;
#pragma unroll
    for (int c = 0; c < 8; ++c) { const u32x4 w = kp[c]; s += q[8 * c] * bflo(w.x) + q[8 * c + 1] * bfhi(w.x) + q[8 * c + 2] * bflo(w.y) + q[8 * c + 3] * bfhi(w.y) + q[8 * c + 4] * bflo(w.z) + q[8 * c + 5] * bfhi(w.z) + q[8 * c + 6] * bflo(w.w) + q[8 * c + 7] * bfhi(w.w); }
    s += __shfl_xor(s, 1); s *= SCALE;
    const float mn = fmaxf(m, s), al = __expf(m - mn), p = __expf(s - mn); m = mn; l = l * al + p;
    const u32x4* vp = (const u32x4*)(Vh + (long)kx * LDK + hf * 64);
#pragma unroll
    for (int c = 0; c < 8; ++c) { const u32x4 w = vp[c];
      o[8 * c] = o[8 * c] * al + p * bflo(w.x); o[8 * c + 1] = o[8 * c + 1] * al + p * bfhi(w.x); o[8 * c + 2] = o[8 * c + 2] * al + p * bflo(w.y); o[8 * c + 3] = o[8 * c + 3] * al + p * bfhi(w.y);
      o[8 * c + 4] = o[8 * c + 4] * al + p * bflo(w.z); o[8 * c + 5] = o[8 * c + 5] * al + p * bfhi(w.z); o[8 * c + 6] = o[8 * c + 6] * al + p * bflo(w.w); o[8 * c + 7] = o[8 * c + 7] * al + p * bfhi(w.w); }
  }
  const float rl = 1.f / l;
#pragma unroll
  for (int i = 0; i < 64; ++i) Ob[(long)qi * LDO + hf * 64 + i] = f2bf(o[i] * rl);
}
#endif
}

struct Args { const float* in[32]; float* out; unsigned char* ws; int ph_lo, ph_hi; };
enum { I_X = 0, I_C, I_CTX, I_CCTX, I_WMOD, I_BMOD, I_NPRE, I_NPOST, I_WIN, I_QN, I_KN, I_WAO, I_WPG, I_PSC, I_WPO, I_MU, I_W0, I_W2, I_A0, I_A2, I_G2, I_KK, I_KA, I_RK, I_LNW, I_LNB, I_WRO, I_WOUT,
       I_WRT, I_WEG, I_WEU, I_WED };
typedef __attribute__((address_space(4))) const unsigned char* kargp_t;
struct InTab {
    __device__ __forceinline__ const float* operator[](int i) const {
#if defined(__HIP_DEVICE_COMPILE__)
        kargp_t ka = (kargp_t)__builtin_amdgcn_kernarg_segment_ptr(); asm volatile("" : "+s"(ka)); return (const float*)*(__attribute__((address_space(4))) const uintptr_t*)(ka + 8 * i);
#else
        return nullptr;
#endif
    }
};
struct ArgView { InTab in; float* out; };
struct F {
    LAS unsigned char* lds; const ArgView* a; unsigned char* ws;
    int tid, lane, wave, vcu, G, gw, NGW;
};
__device__ __forceinline__ F refresh(const F& f0) { F f = f0; unsigned zz = 0u; asm volatile("v_mov_b32 %0, 0" : "=v"(zz)); int t = f0.wave * 64 + (int)__builtin_amdgcn_mbcnt_hi(~0u, __builtin_amdgcn_mbcnt_lo(~0u, zz)); f.tid = t; f.lane = t & 63; f.wave = __builtin_amdgcn_readfirstlane(t >> 6); f.gw = f.vcu * NWAVES + f.wave; return f; }
__device__ __forceinline__ int panel_of(int idx, bool keep) { return keep ? idx : (idx >> 4) * 17 + 1 + (idx & 15); }
__device__ __forceinline__ int row_of(int idx, bool keep) { return keep ? idx : (idx >> 12) * TS + CTXL + (idx & 4095); }

template <int MAP> __device__ __forceinline__ int cvt_map(int n0) { return MAP == 0 ? n0 : MAP == 1 ? (n0 < COL_GATE ? n0 : n0 + (PA_W - COL_GATE)) : MAP == 2 ? ((n0 >> 7) * 256 + (n0 & 127)) : ((n0 >> 7) * 256 + 128 + (n0 & 127)); }
template <int MAP> __device__ __forceinline__ void cvt_T(const F& f, const float* src, int nb, int K, int N, bf16_t* dst, int dst_batch_rows, int& off, int vgw = -1, int vngw = 0) {
    LAS float* scr = (LAS float*)(f.lds + f.wave * (64 * 65 * 4));
    int lane = f.lane; asm volatile("" : "+v"(lane));
    const int nblk = N / 64, per = (K / 64) * nblk, items = nb * per;
    const int ks = lane >> 4, n4 = (lane & 15) * 4, nsub = lane >> 3, c = lane & 7;
    int gwl = vngw ? vgw : f.gw, ngwl = vngw ? vngw : f.NGW; asm volatile("" : "+s"(gwl));
    for (int it = gwl; it < items; it += ngwl) {
        const int b = it / per, rem = it % per, kb = rem / nblk, nbk = rem % nblk, k0 = 64 * kb, n0 = 64 * nbk;
        const float* W = src + (size_t)b * K * N + (size_t)k0 * N + n0 + n4;
        f32x4 v[16];
#pragma unroll
        for (int i = 0; i < 16; ++i) v[i] = __builtin_nontemporal_load((const f32x4*)(W + (size_t)(4 * i + ks) * N));
#pragma unroll
        for (int i = 0; i < 16; ++i) { LAS float* d = scr + (4 * i + ks) * 65 + n4; d[0] = v[i].x; d[1] = v[i].y; d[2] = v[i].z; d[3] = v[i].w; }
        LDS_WAIT(); asm volatile("" ::: "memory");
        bf16_t* drow = dst + ((size_t)b * dst_batch_rows + cvt_map<MAP>(n0)) * K + k0 + 8 * c;
#pragma unroll
        for (int j = 0; j < 8; ++j) { const int n = nsub + 8 * j; const LAS float* sp = scr + (8 * c) * 65 + n;
            u32x4 o; o.x = pk2(sp[0 * 65], sp[1 * 65]); o.y = pk2(sp[2 * 65], sp[3 * 65]); o.z = pk2(sp[4 * 65], sp[5 * 65]); o.w = pk2(sp[6 * 65], sp[7 * 65]);
            *(u32x4*)(drow + (size_t)n * K) = o; }
        LDS_WAIT(); asm volatile("" ::: "memory");
    }
    off += items;
}
__device__ __forceinline__ void cvt_wb(const F& f, int l, int vgw, int vngw) {
    const ArgView& a = *f.a; int off = 0; unsigned char* wb = f.ws + WS_WB + (size_t)l * WB_BYTES;
    cvt_T<1>(f, a.in[I_WIN] + (size_t)l * 2048 * N_IN, 1, 2048, N_IN, (bf16_t*)(wb + WB_WIN), 0, off, vgw, vngw);
    cvt_T<0>(f, a.in[I_WAO] + (size_t)l * 1024 * 2048, 1, 1024, 2048, (bf16_t*)(wb + WB_WA), 0, off, vgw, vngw);
    cvt_T<0>(f, a.in[I_WPO] + (size_t)l * 1024 * 2048, 1, 1024, 2048, (bf16_t*)(wb + WB_WP), 0, off, vgw, vngw);
    cvt_T<0>(f, a.in[I_WRO] + (size_t)l * 1024 * 2048, 1, 1024, 2048, (bf16_t*)(wb + WB_WR), 0, off, vgw, vngw);
    cvt_T<0>(f, a.in[I_WOUT] + (size_t)l * 2048 * 2048, 1, 2048, 2048, (bf16_t*)(wb + WB_WOUT), 0, off, vgw, vngw);
    cvt_T<0>(f, a.in[I_WPG] + (size_t)l * 4 * 256 * 256, 4, 256, 256, (bf16_t*)(wb + WB_WPG), 256, off, vgw, vngw);
    cvt_T<0>(f, a.in[I_W2] + (size_t)l * 2 * 64 * 1024, 2, 64, 1024, (bf16_t*)(wb + WB_W2), 1024, off, vgw, vngw);
    cvt_T<0>(f, a.in[I_A2] + (size_t)l * 2 * 64 * 1024, 2, 64, 1024, (bf16_t*)(wb + WB_A2), 1024, off, vgw, vngw);
    cvt_T<0>(f, a.in[I_G2] + (size_t)l * 320 * 1024, 1, 320, 1024, (bf16_t*)(wb + WB_G2), 0, off, vgw, vngw);
}
__device__ __forceinline__ void phase_prologue(const F& f0) {
    const F f = refresh(f0);
    const ArgView& a = *f.a;
    LAS float* S = (LAS float*)f.lds; LAS float* Pp = S + 5 * 2048;
    for (int i = f.tid; i < 5 * 2048; i += NTHR) { const int m = i >> 11, k = i & 2047; const float v = (m < 4) ? a.in[I_C][m * 2048 + k] : a.in[I_CCTX][k]; S[i] = v / (1.0f + __expf(-v)); }
    __syncthreads();
    float* MOD = (float*)(f.ws + WS_MOD);
    for (int u = f.vcu; u < 2 * 96; u += f.G) {
        int ln = f.lane; asm volatile("" : "+v"(ln));
        const int l = u / 96, cb = u % 96, c4 = (ln & 31) * 4, kp = ln >> 5;
        const float* W = a.in[I_WMOD] + (size_t)l * 2048 * 12288 + cb * 128 + c4;
        f32x4 a0 = {0.f, 0.f, 0.f, 0.f}, a1 = a0, a2 = a0, a3 = a0, a4 = a0;
#pragma unroll 8
        for (int k = f.wave * 256 + kp; k < f.wave * 256 + 256; k += 2) { const f32x4 w4 = *(const f32x4*)(W + (size_t)k * 12288); a0 += w4 * S[k]; a1 += w4 * S[2048 + k]; a2 += w4 * S[4096 + k]; a3 += w4 * S[6144 + k]; a4 += w4 * S[8192 + k]; }
        const int ksl = f.wave * 2 + kp;
        *(LAS f32x4*)(Pp + (ksl * 5 + 0) * 128 + c4) = a0; *(LAS f32x4*)(Pp + (ksl * 5 + 1) * 128 + c4) = a1; *(LAS f32x4*)(Pp + (ksl * 5 + 2) * 128 + c4) = a2; *(LAS f32x4*)(Pp + (ksl * 5 + 3) * 128 + c4) = a3; *(LAS f32x4*)(Pp + (ksl * 5 + 4) * 128 + c4) = a4;
        __syncthreads();
        for (int o = f.tid; o < 5 * 128; o += NTHR) { const int m = o >> 7, col = o & 127; float sum = 0.f;
#pragma unroll
            for (int q = 0; q < 16; ++q) sum += Pp[(q * 5 + m) * 128 + col];
            MOD[(size_t)(l * 5 + m) * 12288 + cb * 128 + col] = sum + a.in[I_BMOD][l * 12288 + cb * 128 + col]; }
        __syncthreads();
    }
    __syncthreads();
    cvt_wb(f, 0, f.gw, f.NGW);
}

__device__ __forceinline__ void row_ld_f32(const float* p, f32x4 (&v)[8], int lane) {
#pragma unroll
    for (int j = 0; j < 8; ++j) v[j] = *(const f32x4*)(p + (j * 64 + lane) * 4);
}
__device__ __forceinline__ void row_ld_bf16(const bf16_t* p, f32x4 (&v)[8], int lane) {
#pragma unroll
    for (int j = 0; j < 8; ++j) { const u32x2 w = *(const u32x2*)(p + (j * 64 + lane) * 4); v[j] = (f32x4){bflo(w.x), bfhi(w.x), bflo(w.y), bfhi(w.y)}; }
}
__device__ __forceinline__ float row_rstd(const f32x4 (&v)[8]) {
    float s = 0.f;
#pragma unroll
    for (int j = 0; j < 8; ++j) s += (v[j].x * v[j].x + v[j].y * v[j].y) + (v[j].z * v[j].z + v[j].w * v[j].w);
    return rsqrtf(wave_sum(s) * (1.0f / D) + NORM_EPS);
}
__device__ __forceinline__ void row_modnorm(const f32x4 (&v)[8], float rstd, const float* g, const float* shift, const float* scale, f32x4 (&y)[8], int lane) {
#pragma unroll
    for (int j = 0; j < 8; ++j) { const int e = (j * 64 + lane) * 4; const f32x4 gg = *(const f32x4*)(g + e), sh = *(const f32x4*)(shift + e), sc = *(const f32x4*)(scale + e);
        y[j] = v[j] * rstd * gg * (sc + 1.0f) + sh; }
}
__device__ __forceinline__ void row_st_bf16(bf16_t* p, const f32x4 (&y)[8], int lane) {
#pragma unroll
    for (int j = 0; j < 8; ++j) { u32x2 w; w.x = pk2(y[j].x, y[j].y); w.y = pk2(y[j].z, y[j].w); *(u32x2*)(p + (j * 64 + lane) * 4) = w; }
}
__device__ __forceinline__ const float* mod_vec(const F& f, int l, int row, int chunk) {
    const int b = row / TS, t = row % TS; const int m = (t < CTXL) ? 4 : b;
    return (const float*)(f.ws + WS_MOD) + (size_t)(l * 5 + m) * 12288 + chunk * 2048;
}

__device__ __forceinline__ void phase_norm1(const F& f0, int l) {
    const F f = refresh(f0);
    const ArgView& a = *f.a; const bf16_t* XS = (const bf16_t*)(f.ws + WS_XS); bf16_t* H = (bf16_t*)(f.ws + WS_H);
    for (int row = f.gw; row < R; row += f.NGW) {
        const int b = row / TS, t = row % TS; f32x4 v[8];
        if (l == 0) { const float* src = (t < CTXL) ? a.in[I_CTX] + ((size_t)b * CTXL + t) * D : a.in[I_X] + ((size_t)b * SEQ + (t - CTXL)) * D; row_ld_f32(src, v, f.lane); }
        else row_ld_bf16(XS + (size_t)row * D, v, f.lane);
        f32x4 gg[8], sh[8], sc[8]; { const float* gp = a.in[I_NPRE] + (size_t)(l * 2 + 0) * D; const float* shp = mod_vec(f, l, row, 0); const float* scp = mod_vec(f, l, row, 1);
#pragma unroll
          for (int j = 0; j < 8; ++j) { const int e = (j * 64 + f.lane) * 4; gg[j] = *(const f32x4*)(gp + e); sh[j] = *(const f32x4*)(shp + e); sc[j] = *(const f32x4*)(scp + e); } }
        asm volatile("" ::: "memory");
        const float rstd = row_rstd(v); f32x4 y[8];
#pragma unroll
        for (int j = 0; j < 8; ++j) y[j] = v[j] * rstd * gg[j] * (sc[j] + 1.0f) + sh[j];
        row_st_bf16(H + (size_t)row * D, y, f.lane);
    }
}

struct SchedTiles { static constexpr bool GATHER = false;
    const char* A; const char* B; size_t a_tile, b_tile; int G, c, nM, nN; bool keep;
    __device__ __forceinline__ bool next(int i, pg8::Unit& u) const { const int L = i * G + c; if (L >= nM * nN) return false; int pm, pn; pg8::tile_of(L, nM, nN, pm, pn);
        pm = panel_of(pm, keep); u.A = A + (size_t)pm * a_tile; u.B = B + (size_t)pn * b_tile; u.pm = pm; u.pn = pn; u.aux = pn * 256; return true; }
};
struct SchedP { static constexpr bool GATHER = false;
    const char* A; const char* B; int G, c; bool keep;
    __device__ __forceinline__ bool next(int i, pg8::Unit& u) const { const int L = i * G + c; int pm, pn;
        if (keep) { if (L >= (R / 256) * NP_TILES) return false; pg8::tile_of(L, R / 256, NP_TILES, pm, pn); }
        else { constexpr int NL = NBATCH * 16 * NP_TILES; if (L >= NL + NBATCH * 15) return false;
            if (L < NL) { pg8::tile_of(L, NBATCH * 16, NP_TILES, pm, pn); pm = panel_of(pm, false); } else { const int x = L - NL, t = x % 15; pm = (x / 15) * 17; pn = t < 2 ? 4 + t : 8 + t; } }
        u.A = A + (size_t)pm * 256 * 2048 * 2; u.B = B + (size_t)pn * 256 * 2048 * 2; u.pm = pm; u.pn = pn; u.aux = pn * 256; return true; }
};
struct EpiP { bf16_t* PA; bf16_t* PG;
    __device__ __forceinline__ bool operator()(pg8::Acc& acc, const pg8::Unit& u, int wr, int wc, int fr, int fq) const {
        asm volatile("" : "+v"(fr), "+v"(fq));
        if (u.pn < 25) {
#pragma unroll
            for (int ai = 0; ai < 2; ++ai)
#pragma unroll
                for (int m = 0; m < 4; ++m) { bf16_t* rowp = PA + (size_t)(u.pm * 256 + 128 * ai + 64 * wr + 16 * m + fr) * PA_W + u.pn * 256 + 32 * wc + 8 * fq;
#pragma unroll
                    for (int bj = 0; bj < 2; ++bj) pg8::st8(rowp + 128 * bj, acc[ai][bj][m][0], acc[ai][bj][m][1]); }
        } else {
            bf16_t* tb = PG + (((size_t)u.pm * 24 + (u.pn - 25)) * 8 + (wr * 4 + wc)) * (16 * 64 * 8) + (fq * 16 + fr) * 8;
#pragma unroll
            for (int ai = 0; ai < 2; ++ai)
#pragma unroll
                for (int m = 0; m < 4; ++m)
#pragma unroll
                    for (int bj = 0; bj < 2; ++bj) { f32x4 v0 = acc[ai][bj][m][0], v1 = acc[ai][bj][m][1];
#pragma unroll
                        for (int j = 0; j < 4; ++j) { v0[j] = 1.0f + __expf(-fminf(fmaxf(v0[j], -30.f), 30.f)); v1[j] = 1.0f + __expf(-fminf(fmaxf(v1[j], -30.f), 30.f)); }
                        pg8::st8(tb + (ai * 8 + m * 2 + bj) * (64 * 8), v0, v1); }
        }
        return false; }
};
struct EpiStore { bf16_t* C; int ldc; const float* colscale;
    __device__ __forceinline__ bool operator()(pg8::Acc& acc, const pg8::Unit& u, int wr, int wc, int fr, int fq) const {
        asm volatile("" : "+v"(fr), "+v"(fq));
#pragma unroll
        for (int bj = 0; bj < 2; ++bj) { const int col = u.aux + 128 * bj + 32 * wc + 8 * fq;
            f32x4 s0 = (f32x4){1.f, 1.f, 1.f, 1.f}, s1 = s0; if (colscale) { s0 = *(const f32x4*)(colscale + col); s1 = *(const f32x4*)(colscale + col + 4); }
#pragma unroll
            for (int ai = 0; ai < 2; ++ai)
#pragma unroll
                for (int m = 0; m < 4; ++m) pg8::st8(C + (size_t)(u.pm * 256 + 128 * ai + 64 * wr + 16 * m + fr) * ldc + col, acc[ai][bj][m][0] * s0, acc[ai][bj][m][1] * s1); }
        return false; }
};

__device__ __forceinline__ void ld8bf(const bf16_t* p, float (&x)[8]) { const u32x4 w = *(const u32x4*)p; x[0] = bflo(w.x); x[1] = bfhi(w.x); x[2] = bflo(w.y); x[3] = bfhi(w.y); x[4] = bflo(w.z); x[5] = bfhi(w.z); x[6] = bflo(w.w); x[7] = bfhi(w.w); }
__device__ __forceinline__ void st8bf(bf16_t* p, const float (&x)[8]) { u32x4 w; w.x = pk2(x[0], x[1]); w.y = pk2(x[2], x[3]); w.z = pk2(x[4], x[5]); w.w = pk2(x[6], x[7]); *(u32x4*)p = w; }
template <int WIN> __device__ __forceinline__ void pool_item(const bf16_t* PA, bf16_t* PL, int row, int ch) {
    const int t = row % TS; const bool is_lat = t >= CTXL; const int tt = is_lat ? t - CTXL : t, Tq = is_lat ? SEQ : CTXL;
    const int lo = max(tt - WIN / 2, 0), hi = min(tt + WIN - WIN / 2, Tq);
    const bf16_t* pc = PA + (size_t)(row - tt) * PA_W + COL_POOL + ch * 8; float sum[8], x[8], self[8];
#pragma unroll
    for (int j = 0; j < 8; ++j) sum[j] = 0.f;
#pragma unroll
    for (int d = 0; d < WIN; ++d) { const int p = tt - WIN / 2 + d; const bool ok = (p >= 0) && (p < Tq); const int pcl = min(max(p, 0), Tq - 1); ld8bf(pc + (size_t)pcl * PA_W, x); const float wgt = ok ? 1.f : 0.f;
#pragma unroll
        for (int j = 0; j < 8; ++j) sum[j] += wgt * x[j]; if (d == WIN / 2) {
#pragma unroll
            for (int j = 0; j < 8; ++j) self[j] = x[j]; } }
    const float rc = 1.0f / (float)(hi - lo);
#pragma unroll
    for (int j = 0; j < 8; ++j) sum[j] = sum[j] * rc - self[j];
    st8bf(PL + (size_t)row * 1024 + ch * 8, sum);
}
__device__ __forceinline__ void phase_prep_rows(const F& f0, int l) {
    const F f = refresh(f0);
    const ArgView& a = *f.a; unsigned char* T = f.ws + WS_T;
    const bf16_t* PA = (const bf16_t*)(T + T_PA);
    bf16_t* QB = (bf16_t*)(T + T_QB); bf16_t* KB = (bf16_t*)(T + T_KB); bf16_t* VB = (bf16_t*)(T + T_VB); bf16_t* PL = (bf16_t*)(f.ws + WS_PL);
    bf16_t* KK = (bf16_t*)(T + T_KK); bf16_t* RR = (bf16_t*)(T + T_RR); bf16_t* VV = (bf16_t*)(T + T_VV); bf16_t* KS = (bf16_t*)(T + T_KS); bf16_t* LA = (bf16_t*)(T + T_LA);
    const float* mu = a.in[I_MU] + (size_t)l * NSHIFT; const float* k_k = a.in[I_KK] + (size_t)l * 1024;
    const float* qn = a.in[I_QN] + (size_t)l * 128; const float* kn = a.in[I_KN] + (size_t)l * 128;
    LAS float* cst = (LAS float*)(f.lds + f.wave * 512);
    LAS float* lmu = (LAS float*)(f.lds + NWAVES * 512); LAS float* lkk = lmu + NSHIFT; LAS float* lqk = lkk + 1024;
    for (int i = f.tid; i < NSHIFT; i += NTHR) lmu[i] = mu[i];
    for (int i = f.tid; i < 1024; i += NTHR) lkk[i] = k_k[i];
    if (f.tid < 256) lqk[f.tid] = f.tid < 128 ? qn[f.tid] : kn[f.tid - 128];
    LDS_WAIT(); __syncthreads();
    for (int row = f.gw; row < R; row += f.NGW) {
        int lane = f.lane; asm volatile("" : "+v"(lane));
        const int t = row % TS; const bool is_lat = t >= CTXL; const int tt = is_lat ? t - CTXL : t, Tq = is_lat ? SEQ : CTXL;
        const bool hp = tt > 0, hn = tt < Tq - 1;
        const bf16_t* pu = PA + (size_t)row * PA_W + COL_R;
        u32x4 ru[8], rp[8], rn[8];
#pragma unroll
        for (int it = 0; it < 8; ++it) { const int ch = lane + 64 * it; const int c0 = (ch < NSHIFT / 8 ? ch : 0) * 8; const u32x4 zz = {0u, 0u, 0u, 0u};
            ru[it] = *(const u32x4*)(pu + c0); rp[it] = hp ? *(const u32x4*)(pu - PA_W + c0) : zz; rn[it] = hn ? *(const u32x4*)(pu + PA_W + c0) : zz;
 }
        u32x4 qx1[2], qx2[2]; u32x2 vraw;
        { const bf16_t* pr0 = PA + (size_t)row * PA_W;
#pragma unroll
          for (int pass = 0; pass < 2; ++pass) { const int slot = lane + 64 * pass; const int sl = slot < 80 ? slot : 0; const int hh = sl >> 3, sub = sl & 7, a2 = sub >> 2, fb = sub & 3, base = hh * 128 + a2 * 64 + 8 * fb;
              qx1[pass] = *(const u32x4*)(pr0 + base); qx2[pass] = *(const u32x4*)(pr0 + base + 32);
 }
          vraw = *(const u32x2*)(pr0 + COL_V + lane * 4); }
        asm volatile("" ::: "memory");
#pragma unroll
        for (int it = 0; it < 8; ++it) { const int ch = lane + 64 * it; if (ch < NSHIFT / 8) { const int c0 = ch * 8;
            float u[8], p[8], n[8], s[8];
            u[0] = bflo(ru[it].x); u[1] = bfhi(ru[it].x); u[2] = bflo(ru[it].y); u[3] = bfhi(ru[it].y); u[4] = bflo(ru[it].z); u[5] = bfhi(ru[it].z); u[6] = bflo(ru[it].w); u[7] = bfhi(ru[it].w);
            p[0] = bflo(rp[it].x); p[1] = bfhi(rp[it].x); p[2] = bflo(rp[it].y); p[3] = bfhi(rp[it].y); p[4] = bflo(rp[it].z); p[5] = bfhi(rp[it].z); p[6] = bflo(rp[it].w); p[7] = bfhi(rp[it].w);
            n[0] = bflo(rn[it].x); n[1] = bfhi(rn[it].x); n[2] = bflo(rn[it].y); n[3] = bfhi(rn[it].y); n[4] = bflo(rn[it].z); n[5] = bfhi(rn[it].z); n[6] = bflo(rn[it].w); n[7] = bfhi(rn[it].w);
            const f32x4 m0 = *(const LAS f32x4*)(lmu + c0), m1 = *(const LAS f32x4*)(lmu + c0 + 4);
#pragma unroll
            for (int j = 0; j < 8; ++j) { const float mj = j < 4 ? m0[j] : m1[j - 4]; s[j] = u[j] + (0.5f * (p[j] + n[j]) - u[j]) * mj; }
            if (it < 2) st8bf(RR + (size_t)row * 1024 + c0, s);
            else if (it < 4) { st8bf(KS + (size_t)row * 1024 + (c0 - 1024), s);
                const f32x4 k0 = *(const LAS f32x4*)(lkk + c0 - 1024), k1 = *(const LAS f32x4*)(lkk + c0 - 1024 + 4); float q[8], ss = 0.f;
#pragma unroll
                for (int j = 0; j < 8; ++j) { q[j] = s[j] * (j < 4 ? k0[j] : k1[j - 4]); ss += q[j] * q[j]; }
                ss += __shfl_xor(ss, 1); ss += __shfl_xor(ss, 2); ss += __shfl_xor(ss, 4);
                const float inv = 1.0f / fmaxf(sqrtf(ss), 1e-12f);
#pragma unroll
                for (int j = 0; j < 8; ++j) q[j] *= inv;
                st8bf(KK + (size_t)row * 1024 + (c0 - 1024), q); }
            else if (it < 6) st8bf(VV + (size_t)row * 1024 + (c0 - 2048), s);
            else { float o[8]; int dc;
                if (c0 < 3200) { for (int j = 0; j < 8; ++j) o[j] = tanhf_(s[j]); dc = c0 - 3072; }
                else if (c0 < 3328) { for (int j = 0; j < 8; ++j) o[j] = s[j]; dc = 128 + (c0 - 3200); }
                else { for (int j = 0; j < 8; ++j) o[j] = sigmoidf_(s[j]); dc = 256 + (c0 - 3328); }
                st8bf(LA + (size_t)row * LA_W + dc, o); }
        } }
        { const int ax = lane >> 5, fi = lane & 31; const int pos = is_lat ? (ax == 0 ? tt / GRIDW : tt % GRIDW) : 0;
          const float inv = exp2f(-(float)(2 * fi) * (1.0f / 64.0f) * 13.287712379549449f);
          float sn, cs; sincosf((float)pos * inv, &sn, &cs); cst[lane] = cs; cst[64 + lane] = sn;
          LDS_WAIT(); asm volatile("" ::: "memory");
          const bf16_t* pr = PA + (size_t)row * PA_W;
#pragma unroll
          for (int pass = 0; pass < 2; ++pass) { const int slot = lane + 64 * pass; const bool act = slot < 80; const int sl = act ? slot : 0;
              const int hh = sl >> 3, sub = sl & 7, a2 = sub >> 2, fb = sub & 3, base = hh * 128 + a2 * 64 + 8 * fb;
              float x1[8], x2[8]; { const u32x4 wa = qx1[pass], wb2 = qx2[pass];
                  x1[0] = bflo(wa.x); x1[1] = bfhi(wa.x); x1[2] = bflo(wa.y); x1[3] = bfhi(wa.y); x1[4] = bflo(wa.z); x1[5] = bfhi(wa.z); x1[6] = bflo(wa.w); x1[7] = bfhi(wa.w);
                  x2[0] = bflo(wb2.x); x2[1] = bfhi(wb2.x); x2[2] = bflo(wb2.y); x2[3] = bfhi(wb2.y); x2[4] = bflo(wb2.z); x2[5] = bfhi(wb2.z); x2[6] = bflo(wb2.w); x2[7] = bfhi(wb2.w); }
              float ss = 0.f;
#pragma unroll
              for (int j = 0; j < 8; ++j) ss += x1[j] * x1[j] + x2[j] * x2[j];
              ss += __shfl_xor(ss, 1); ss += __shfl_xor(ss, 2); ss += __shfl_xor(ss, 4);
              const float rstd = rsqrtf(ss * (1.0f / 128.0f) + NORM_EPS);
              const LAS float* nw = lqk + (hh < 8 ? 0 : 128) + a2 * 64 + 8 * fb; const f32x4 w1a = *(const LAS f32x4*)nw, w1b = *(const LAS f32x4*)(nw + 4), w2a = *(const LAS f32x4*)(nw + 32), w2b = *(const LAS f32x4*)(nw + 36);
              const f32x4 c0v = *(const LAS f32x4*)(cst + a2 * 32 + 8 * fb), c1v = *(const LAS f32x4*)(cst + a2 * 32 + 8 * fb + 4), s0v = *(const LAS f32x4*)(cst + 64 + a2 * 32 + 8 * fb), s1v = *(const LAS f32x4*)(cst + 64 + a2 * 32 + 8 * fb + 4);
              float y1[8], y2[8];
#pragma unroll
              for (int j = 0; j < 8; ++j) { const float a1 = x1[j] * rstd * (j < 4 ? w1a[j] : w1b[j - 4]), b1 = x2[j] * rstd * (j < 4 ? w2a[j] : w2b[j - 4]); const float cc = j < 4 ? c0v[j] : c1v[j - 4], sn2 = j < 4 ? s0v[j] : s1v[j - 4];
                  y1[j] = is_lat ? a1 * cc - b1 * sn2 : a1; y2[j] = is_lat ? b1 * cc + a1 * sn2 : b1; }
              if (act) { bf16_t* dst = hh < 8 ? QB + (size_t)row * 1024 + hh * 128 : KB + (size_t)row * 256 + (hh - 8) * 128; st8bf(dst + a2 * 64 + 8 * fb, y1); st8bf(dst + a2 * 64 + 32 + 8 * fb, y2); } }
          *(u32x2*)(VB + (size_t)row * 256 + lane * 4) = vraw;
          asm volatile("" ::: "memory"); }
    }
    { int gt = f.vcu * NTHR + f.tid; asm volatile("" : "+v"(gt));
      for (int idx = gt; idx < R * 128; idx += f.G * NTHR) { const int g = idx / (R * 32), rem = idx % (R * 32), row = rem >> 5, ch = g * 32 + (rem & 31);
          if (g == 0) pool_item<2>(PA, PL, row, ch); else if (g == 1) pool_item<4>(PA, PL, row, ch); else if (g == 2) pool_item<8>(PA, PL, row, ch); else pool_item<16>(PA, PL, row, ch); } }
}
namespace lr { constexpr int P320 = 656; }
__device__ __forceinline__ void phase_prep_lora(const F& f0, int l) {
    const F f = refresh(f0);
    const unsigned char* wb = f.ws + WS_WB + (size_t)l * WB_BYTES; unsigned char* T = f.ws + WS_T; bf16_t* Gg = (bf16_t*)(f.ws + WS_G);
    const int cb = f.vcu & 15, rg = f.vcu >> 4, ngrp = f.G >> 4;
    for (int i = f.tid; i < 64 * 40; i += NTHR) { const int n = i / 40, c = i % 40; *(LAS u32x4*)(f.lds + n * lr::P320 + c * 16) = *(const u32x4*)((const bf16_t*)(wb + WB_G2) + (size_t)(cb * 64 + n) * 320 + c * 8); }
    LDS_WAIT(); __syncthreads();
    for (int t = rg + ngrp * f.wave; t < R / 16; t += ngrp * NWAVES) {
        int lane = f.lane; asm volatile("" : "+v"(lane));
        const int r0 = t * 16, fr = lane & 15, fq = lane >> 4; const size_t row = (size_t)(r0 + fr);
        const bf16_t* LAp = (const bf16_t*)(T + T_LA) + row * LA_W + 256 + 8 * fq;
        bf16x8 afa[10];
#pragma unroll
        for (int i = 0; i < 10; ++i) afa[i] = *(const bf16x8*)(LAp + 32 * i);
#pragma unroll
        for (int nt = 0; nt < 4; ++nt) { f32x4 acc = (f32x4){0.f, 0.f, 0.f, 0.f};
#pragma unroll
            for (int ks = 0; ks < 10; ++ks) acc = __builtin_amdgcn_mfma_f32_16x16x32_bf16(*(const LAS bf16x8*)(f.lds + (16 * nt + fr) * lr::P320 + (32 * ks + 8 * fq) * 2), afa[ks], acc, 0, 0, 0);
            *(u32x2*)(Gg + row * 1024 + cb * 64 + 16 * nt + 4 * fq) = rk::pk4(acc); }
    }
}

__device__ __forceinline__ void phase_attn(const F& f0, bool keep) {
    const F f = refresh(f0);
    unsigned char* T = f.ws + WS_T; const bf16_t* QB = (const bf16_t*)(T + T_QB); const bf16_t* KB = (const bf16_t*)(T + T_KB); const bf16_t* VB = (const bf16_t*)(T + T_VB); bf16_t* AT = (bf16_t*)(T + T_AT);
    const int nu = keep ? 544 : 512;
    for (int u = f.vcu; u < nu; u += f.G) {
        int b, h, row0, seq;
        if (u < 512) { b = u >> 7; const int rem = u & 127; h = rem >> 4; row0 = b * TS + CTXL + (rem & 15) * 256; seq = TS; }
        else { const int uc = u - 512; b = uc >> 3; h = uc & 7; row0 = b * TS; seq = CTXL; }
        int t2 = f.tid; asm volatile("" : "+v"(t2));
        att::attn_unit(QB + (size_t)row0 * 1024 + h * 128, KB + (size_t)b * TS * 256 + (h >> 2) * 128, VB + (size_t)b * TS * 256 + (h >> 2) * 128, AT + (size_t)row0 * 1024 + h * 128, seq, (char*)f.lds, t2);
    }
}
struct SchedPool { static constexpr bool GATHER = false; const char* A; const char* B; int G, c, nM; bool keep;
    __device__ __forceinline__ bool next(int i, pg8::Unit& u) const { const int L = i * G + c; if (L >= nM * 4) return false; const int pm = panel_of(L >> 2, keep), g = L & 3;
        u.A = A + ((size_t)pm * 256 * 1024 + g * 256) * 2; u.B = B + (size_t)g * 65536 * 2; u.pm = pm; u.pn = g; u.aux = g * 256; return true; }
};
namespace rk {
constexpr int LST = 144, MSZ = 64 * LST;
enum { M_AT = 0, M_BT, M_KT, M_RT, M_VT, M_MTAK, M_NTRB, M_NTRK, M_P0, M_P1, M_T0, M_T1, M_Q0, M_AP, M_PP, M_CNT };
constexpr int OFF_GC = M_CNT * MSZ, OFF_SEG = OFF_GC + 256;
struct Fr2 { bf16x8 a, b; };
__device__ __forceinline__ Fr2 rfr(LAS unsigned char* M, int t, int fr, int fq) { Fr2 r; const LAS unsigned char* p = M + (16 * t + fr) * LST + 16 * fq; r.a = *(const LAS bf16x8*)p; r.b = *(const LAS bf16x8*)(p + 64); return r; }
__device__ __forceinline__ Fr2 cfr(LAS unsigned char* M, int t, int lane) {
    const unsigned ad = (unsigned)(uintptr_t)M + (unsigned)((8 * (lane >> 4) + ((lane & 15) >> 2)) * LST + (16 * t + 4 * (lane & 3)) * 2);
    s16x4 a0, a1, b0, b1;
    asm volatile("ds_read_b64_tr_b16 %0, %4\n\tds_read_b64_tr_b16 %1, %4 offset:576\n\tds_read_b64_tr_b16 %2, %4 offset:4608\n\tds_read_b64_tr_b16 %3, %4 offset:5184\n\ts_waitcnt lgkmcnt(0)"
                 : "=&v"(a0), "=&v"(a1), "=&v"(b0), "=&v"(b1) : "v"(ad) : "memory");
    Fr2 r; r.a = (bf16x8){a0[0], a0[1], a0[2], a0[3], a1[0], a1[1], a1[2], a1[3]}; r.b = (bf16x8){b0[0], b0[1], b0[2], b0[3], b1[0], b1[1], b1[2], b1[3]}; return r;
}
__device__ __forceinline__ bf16x8 rfa(LAS unsigned char* M, int t, int fr, int fq) { return *(const LAS bf16x8*)(M + (16 * t + fr) * LST + 16 * fq); }
__device__ __forceinline__ void cfr2a(LAS unsigned char* M, int lane, bf16x8 (&o)[2]) {
    const unsigned ad = (unsigned)(uintptr_t)M + (unsigned)((8 * (lane >> 4) + ((lane & 15) >> 2)) * LST + (4 * (lane & 3)) * 2);
    s16x4 r[4];
    asm volatile("ds_read_b64_tr_b16 %0, %4\n\tds_read_b64_tr_b16 %1, %4 offset:576\n\tds_read_b64_tr_b16 %2, %4 offset:32\n\tds_read_b64_tr_b16 %3, %4 offset:608\n\ts_waitcnt lgkmcnt(0)"
                 : "=&v"(r[0]), "=&v"(r[1]), "=&v"(r[2]), "=&v"(r[3]) : "v"(ad) : "memory");
#pragma unroll
    for (int t = 0; t < 2; ++t) o[t] = (bf16x8){r[2 * t][0], r[2 * t][1], r[2 * t][2], r[2 * t][3], r[2 * t + 1][0], r[2 * t + 1][1], r[2 * t + 1][2], r[2 * t + 1][3]};
}
__device__ __forceinline__ void cfr4a(LAS unsigned char* M, int lane, bf16x8 (&o)[4]) {
    const unsigned ad = (unsigned)(uintptr_t)M + (unsigned)((8 * (lane >> 4) + ((lane & 15) >> 2)) * LST + (4 * (lane & 3)) * 2);
    s16x4 r[8];
    asm volatile("ds_read_b64_tr_b16 %0, %8\n\tds_read_b64_tr_b16 %1, %8 offset:576\n\tds_read_b64_tr_b16 %2, %8 offset:32\n\tds_read_b64_tr_b16 %3, %8 offset:608\n\t"
                 "ds_read_b64_tr_b16 %4, %8 offset:64\n\tds_read_b64_tr_b16 %5, %8 offset:640\n\tds_read_b64_tr_b16 %6, %8 offset:96\n\tds_read_b64_tr_b16 %7, %8 offset:672\n\ts_waitcnt lgkmcnt(0)"
                 : "=&v"(r[0]), "=&v"(r[1]), "=&v"(r[2]), "=&v"(r[3]), "=&v"(r[4]), "=&v"(r[5]), "=&v"(r[6]), "=&v"(r[7]) : "v"(ad) : "memory");
#pragma unroll
    for (int t = 0; t < 4; ++t) o[t] = (bf16x8){r[2 * t][0], r[2 * t][1], r[2 * t][2], r[2 * t][3], r[2 * t + 1][0], r[2 * t + 1][1], r[2 * t + 1][2], r[2 * t + 1][3]};
}
__device__ __forceinline__ void cfr4(LAS unsigned char* M, int lane, Fr2 (&o)[4]) {
    const unsigned ad = (unsigned)(uintptr_t)M + (unsigned)((8 * (lane >> 4) + ((lane & 15) >> 2)) * LST + (4 * (lane & 3)) * 2);
    s16x4 r[16];
    asm volatile("ds_read_b64_tr_b16 %0, %16\n\tds_read_b64_tr_b16 %1, %16 offset:576\n\tds_read_b64_tr_b16 %2, %16 offset:4608\n\tds_read_b64_tr_b16 %3, %16 offset:5184\n\t"
                 "ds_read_b64_tr_b16 %4, %16 offset:32\n\tds_read_b64_tr_b16 %5, %16 offset:608\n\tds_read_b64_tr_b16 %6, %16 offset:4640\n\tds_read_b64_tr_b16 %7, %16 offset:5216\n\t"
                 "ds_read_b64_tr_b16 %8, %16 offset:64\n\tds_read_b64_tr_b16 %9, %16 offset:640\n\tds_read_b64_tr_b16 %10, %16 offset:4672\n\tds_read_b64_tr_b16 %11, %16 offset:5248\n\t"
                 "ds_read_b64_tr_b16 %12, %16 offset:96\n\tds_read_b64_tr_b16 %13, %16 offset:672\n\tds_read_b64_tr_b16 %14, %16 offset:4704\n\tds_read_b64_tr_b16 %15, %16 offset:5280\n\ts_waitcnt lgkmcnt(0)"
                 : "=&v"(r[0]), "=&v"(r[1]), "=&v"(r[2]), "=&v"(r[3]), "=&v"(r[4]), "=&v"(r[5]), "=&v"(r[6]), "=&v"(r[7]), "=&v"(r[8]), "=&v"(r[9]), "=&v"(r[10]), "=&v"(r[11]), "=&v"(r[12]), "=&v"(r[13]), "=&v"(r[14]), "=&v"(r[15])
                 : "v"(ad) : "memory");
#pragma unroll
    for (int t = 0; t < 4; ++t) { o[t].a = (bf16x8){r[4 * t][0], r[4 * t][1], r[4 * t][2], r[4 * t][3], r[4 * t + 1][0], r[4 * t + 1][1], r[4 * t + 1][2], r[4 * t + 1][3]};
        o[t].b = (bf16x8){r[4 * t + 2][0], r[4 * t + 2][1], r[4 * t + 2][2], r[4 * t + 2][3], r[4 * t + 3][0], r[4 * t + 3][1], r[4 * t + 3][2], r[4 * t + 3][3]}; }
}
__device__ __forceinline__ f32x4 mm2(const Fr2& first, const Fr2& second, f32x4 acc) { acc = __builtin_amdgcn_mfma_f32_16x16x32_bf16(first.a, second.a, acc, 0, 0, 0); return __builtin_amdgcn_mfma_f32_16x16x32_bf16(first.b, second.b, acc, 0, 0, 0); }
__device__ __forceinline__ int tok_row(int b, int z, int c, int x) { const int p = 64 * c + x; const int t = (z == 0) ? p : (c < 4 ? (CTXL - 1 - p) : (TS + CTXL - 1 - p)); return b * TS + t; }
}
__device__ __forceinline__ void phase_scanA(const F& f0, int l) {
    using namespace rk;
    const F f = refresh(f0);
    const ArgView& a = *f.a; const unsigned char* wb = f.ws + WS_WB + (size_t)l * WB_BYTES;
    unsigned char* T = f.ws + WS_T; float* WD = (float*)(T + T_WD); bf16_t* KD = (bf16_t*)(T + T_KD); bf16_t* BD = (bf16_t*)(T + T_BD); const bf16_t* KK = (const bf16_t*)(T + T_KK);
    const bf16_t* RR = (const bf16_t*)(T + T_RR); const bf16_t* VV = (const bf16_t*)(T + T_VV); const bf16_t* KS = (const bf16_t*)(T + T_KS); const bf16_t* LA = (const bf16_t*)(T + T_LA);
    float* BON = (float*)(f.ws + WS_BON);
    LAS unsigned char* L = f.lds; LAS float* gC = (LAS float*)(L + OFF_GC); LAS float* seg = (LAS float*)(L + OFF_SEG); LAS float* cvec = (LAS float*)(L + OFF_SEG + 2048);
    const int w = f.wave;
    constexpr int NU = NBATCH * RWH * 2 * 68;
    const int u0 = (int)((long)f.vcu * NU / f.G), per = (int)((long)(f.vcu + 1) * NU / f.G) - u0;
    unsigned nkk[4], nrr[4], nvv[4]; bf16x8 nla[2]; u32x2 nks[4], nk2[4], nr2[4];
#define SA_LOAD(u_) do { const int ci_ = (u_) / 68, c_ = (u_) % 68, b_ = ci_ >> 5, h_ = (ci_ >> 1) & 15, z_ = ci_ & 1; \
          \
        { unsigned o_ = ((unsigned)tok_row(b_, z_, c_, 8 * w + 4 * (f.lane >> 5)) * 1024u + (unsigned)(h_ * 64 + 2 * (f.lane & 31))) * 2u; const unsigned st_ = z_ ? 0u - 2048u : 2048u; \
          _Pragma("unroll") for (int e = 0; e < 4; ++e) { nkk[e] = *(const unsigned*)((const char*)KK + o_); nrr[e] = *(const unsigned*)((const char*)RR + o_); nvv[e] = *(const unsigned*)((const char*)VV + o_); o_ += st_; } } \
        { const unsigned rowt_ = (unsigned)tok_row(b_, z_, c_, 16 * (w & 3) + (f.lane & 15)); const unsigned lo_ = (rowt_ * (unsigned)LA_W + (unsigned)(((w >> 2) ? 128 : 0) + z_ * 64 + 8 * (f.lane >> 4))) * 2u; \
          nla[0] = *(const bf16x8*)((const char*)LA + lo_); nla[1] = *(const bf16x8*)((const char*)LA + lo_ + 64u); \
          if (w >= 4) { const unsigned eo_ = (rowt_ * 1024u + (unsigned)(h_ * 64 + 4 * (f.lane >> 4))) * 2u; \
              _Pragma("unroll") for (int ft = 0; ft < 4; ++ft) { nks[ft] = *(const u32x2*)((const char*)KS + eo_ + 32u * ft); nk2[ft] = *(const u32x2*)((const char*)KK + eo_ + 32u * ft); nr2[ft] = *(const u32x2*)((const char*)RR + eo_ + 32u * ft); } } } } while (0)
    if (per > 0) SA_LOAD(u0);
#define SA_CLAIM() do { _Pragma("unroll") for (int e = 0; e < 4; ++e) asm volatile("" : "+v"(nkk[e]), "+v"(nrr[e]), "+v"(nvv[e])); asm volatile("" : "+v"(nla[0]), "+v"(nla[1])); \
        _Pragma("unroll") for (int ft = 0; ft < 4; ++ft) asm volatile("" : "+v"(nks[ft]), "+v"(nk2[ft]), "+v"(nr2[ft])); } while (0)
    SA_CLAIM();
    int cur_ci = -1;
    for (int k = 0; k < per; ++k) { const int u = u0 + k;
        const int ci = u / 68, c = u % 68, b = ci >> 5, h = (ci >> 1) & 15, z = ci & 1;
        int lane = f.lane; asm volatile("" : "+v"(lane));
        const int fr = lane & 15, fq = lane >> 4;
        if (ci != cur_ci) {
            cur_ci = ci; __syncthreads();
            for (int i = f.tid; i < 2 * 64 * 8; i += NTHR) { const int m = i >> 9, n = (i >> 3) & 63, cch = i & 7;
                *(LAS u32x4*)(L + (m ? M_PP : M_AP) * MSZ + n * LST + cch * 16) = *(const u32x4*)((const bf16_t*)(wb + (m ? WB_A2 : WB_W2)) + ((size_t)z * 1024 + h * 64 + n) * 64 + cch * 8); }
            if (f.tid < 256) { const int q = f.tid >> 6, j = f.tid & 63; cvec[f.tid] = q == 0 ? a.in[I_W0][(size_t)(l * 2 + z) * 1024 + h * 64 + j] : q == 1 ? a.in[I_A0][(size_t)(l * 2 + z) * 1024 + h * 64 + j] : q == 2 ? a.in[I_KA][(size_t)l * 1024 + h * 64 + j] : a.in[I_RK][(size_t)l * 1024 + h * 64 + j]; }
            LDS_WAIT(); __syncthreads(); }
        { const int prod = w >> 2, st = w & 3; const size_t rowt = (size_t)tok_row(b, z, c, 16 * st + fr); Fr2 sec; sec.a = nla[0]; sec.b = nla[1]; float bon = 0.f;
          f32x4 acc4[4]; { Fr2 wf[4];
#pragma unroll
            for (int ft = 0; ft < 4; ++ft) wf[ft] = rfr(L + (prod ? M_PP : M_AP) * MSZ, ft, fr, fq);
#pragma unroll
            for (int ft = 0; ft < 4; ++ft) acc4[ft] = mm2(wf[ft], sec, (f32x4){0.f, 0.f, 0.f, 0.f}); }
          const int so0 = (16 * st + fr) * LST + 8 * fq;
          if (prod == 0) {
#pragma unroll
              for (int ft = 0; ft < 4; ++ft) { const f32x4 w0 = *(const LAS f32x4*)(cvec + 16 * ft + 4 * fq); f32x4 o;
#pragma unroll
                  for (int e = 0; e < 4; ++e) o[e] = -0.60653066f * sigmoidf_(w0[e] + acc4[ft][e]);
                  *(LAS u32x2*)(L + M_P1 * MSZ + so0 + 32 * ft) = pk4(o); } }
          else {
#pragma unroll
              for (int ft = 0; ft < 4; ++ft) { const int j0 = 16 * ft + 4 * fq; const f32x4 a0 = *(const LAS f32x4*)(cvec + 64 + j0), ka = *(const LAS f32x4*)(cvec + 128 + j0), rk4 = *(const LAS f32x4*)(cvec + 192 + j0);
                  const f32x4 kv = up4(nks[ft]), kkv = up4(nk2[ft]), rv = up4(nr2[ft]); f32x4 kd, bd;
#pragma unroll
                  for (int e = 0; e < 4; ++e) { const float av = sigmoidf_(a0[e] + acc4[ft][e]); kd[e] = kv[e] * (1.0f + (av - 1.0f) * ka[e]); bd[e] = kkv[e] * av; bon += rv[e] * kd[e] * rk4[e]; }
                  *(LAS u32x2*)(L + M_T1 * MSZ + so0 + 32 * ft) = pk4(kd); *(LAS u32x2*)(L + M_Q0 * MSZ + so0 + 32 * ft) = pk4(bd); }
              bon += __shfl_xor(bon, 16); bon += __shfl_xor(bon, 32); if (fq == 0) BON[((size_t)z * R + rowt) * 16 + h] = bon; } }
        LDS_WAIT(); __syncthreads();
        { const int jp = lane & 31, th = lane >> 5; float lw0[4], lw1[4]; unsigned kdw[4], bdw[4], kkw[4], rrw[4], vvw[4]; float run0 = 0.f, run1 = 0.f;
#pragma unroll
          for (int e = 0; e < 4; ++e) { const int so = (8 * w + 4 * th + e) * LST + jp * 4; const unsigned lww = *(const LAS unsigned*)(L + M_P1 * MSZ + so); lw0[e] = bflo(lww); lw1[e] = bfhi(lww);
              kdw[e] = *(const LAS unsigned*)(L + M_T1 * MSZ + so); bdw[e] = *(const LAS unsigned*)(L + M_Q0 * MSZ + so); kkw[e] = nkk[e]; rrw[e] = nrr[e]; vvw[e] = nvv[e]; }
          if (k + 1 < per) SA_LOAD(u + 1);
#pragma unroll
          for (int e = 0; e < 4; ++e) { run0 += lw0[e]; lw0[e] = run0; run1 += lw1[e]; lw1[e] = run1; }
          const float o0 = __shfl_xor(run0, 32), o1 = __shfl_xor(run1, 32);
          if (th) *(LAS f32x2*)(seg + w * 64 + 2 * jp) = (f32x2){run0 + o0, run1 + o1};
          LDS_WAIT(); __syncthreads();
          float offs0 = th ? o0 : 0.f, offs1 = th ? o1 : 0.f;
#pragma unroll
          for (int g = 0; g < 8; ++g) if (g < w) { const f32x2 sg = *(const LAS f32x2*)(seg + g * 64 + 2 * jp); offs0 += sg.x; offs1 += sg.y; }
          float ep0 = __expf(offs0), ep1 = __expf(offs1);
#pragma unroll
          for (int e = 0; e < 4; ++e) { const float Lc0 = offs0 + lw0[e], Lc1 = offs1 + lw1[e]; const float el0 = __expf(Lc0), el1 = __expf(Lc1), em0 = __expf(-Lc0), em1 = __expf(-Lc1); const int ro = (8 * w + 4 * th + e) * LST + jp * 4;
              *(LAS unsigned*)(L + M_AT * MSZ + ro) = pk2(-bflo(kkw[e]) * ep0, -bfhi(kkw[e]) * ep1); *(LAS unsigned*)(L + M_BT * MSZ + ro) = pk2(bflo(bdw[e]) * em0, bfhi(bdw[e]) * em1);
              *(LAS unsigned*)(L + M_KT * MSZ + ro) = pk2(bflo(kdw[e]) * em0, bfhi(kdw[e]) * em1); *(LAS unsigned*)(L + M_RT * MSZ + ro) = pk2(bflo(rrw[e]) * el0, bfhi(rrw[e]) * el1);
              *(LAS unsigned*)(L + M_VT * MSZ + ro) = vvw[e]; ep0 = el0; ep1 = el1; if (w == 7 && th == 1 && e == 3) *(LAS f32x2*)(gC + 2 * jp) = (f32x2){el0, el1}; }
        }
        LDS_WAIT(); __syncthreads();
        { const int mat = w >> 1, sh = w & 1; LAS unsigned char* Fm = L + ((mat & 1) ? M_KT : M_BT) * MSZ; LAS unsigned char* Sm = L + ((mat < 2) ? M_AT : M_RT) * MSZ;
          LAS unsigned char* dst = L + (mat == 0 ? M_P0 : mat == 1 ? M_MTAK : mat == 2 ? M_NTRB : M_NTRK) * MSZ;
          Fr2 ff[4];
#pragma unroll
          for (int ft = 0; ft < 4; ++ft) ff[ft] = rfr(Fm, ft, fr, fq);
#pragma unroll
          for (int s2 = 0; s2 < 2; ++s2) { const int st = 2 * sh + s2; const Fr2 sf = rfr(Sm, st, fr, fq); const int y = 16 * st + fr;
              const int d0 = y - 4 * fq, d = d0 + ((mat < 2) ? 0 : 1);
              const int ro = y * LST + 8 * fq;
#pragma unroll
              for (int ft = 0; ft < 4; ++ft) { f32x4 acc = mm2(ff[ft], sf, (f32x4){0.f, 0.f, 0.f, 0.f});
#pragma unroll
                  for (int e = 0; e < 4; ++e) acc[e] = (16 * ft + e < d) ? acc[e] : 0.f;
                  *(LAS u32x2*)(dst + ro + 32 * ft) = pk4(acc);
                  if (mat == 0) {
#pragma unroll
                      for (int e = 0; e < 4; ++e) acc[e] += (16 * ft + e == d0) ? 1.f : 0.f;
                      *(LAS u32x2*)(L + M_T0 * MSZ + ro + 32 * ft) = pk4(acc); } } }
        }
        LDS_WAIT(); __syncthreads();
#pragma unroll
        for (int lv = 0; lv < 6; ++lv) {
            LAS unsigned char* Pc = L + ((lv & 1) ? M_P1 : M_P0) * MSZ; LAS unsigned char* Pn = L + ((lv & 1) ? M_P0 : M_P1) * MSZ;
            LAS unsigned char* Tc = L + ((lv & 1) ? M_T0 : M_T1) * MSZ; LAS unsigned char* Tn = L + ((lv & 1) ? M_T1 : M_T0) * MSZ;
            const int st = w & 3;
            if (st < 2) {
                const f32x4 z4 = (f32x4){0.f, 0.f, 0.f, 0.f};
                if (w < 4) { if (lv < 5) { const bf16x8 sa = rfa(Pc, st, fr, fq); bf16x8 ca[2]; cfr2a(Pc, lane, ca);
                    if (lv == 0) {
#pragma unroll
                        for (int ft = 2; ft < 4; ++ft) *(LAS u32x2*)(Pn + (16 * st + fr) * LST + (16 * ft + 4 * fq) * 2) = (u32x2){0u, 0u}; }
#pragma unroll
                    for (int ft = 0; ft < 2; ++ft) { const f32x4 acc = __builtin_amdgcn_mfma_f32_16x16x32_bf16(ca[ft], sa, z4, 0, 0, 0); *(LAS u32x2*)(Pn + (16 * st + fr) * LST + (16 * ft + 4 * fq) * 2) = pk4(acc); } } }
                else if (lv == 0) { const bf16x8 sa = rfa(L + M_MTAK * MSZ, st, fr, fq); bf16x8 ca[4]; cfr4a(L + M_VT * MSZ, lane, ca);
#pragma unroll
                    for (int ft = 0; ft < 4; ++ft) { const f32x4 acc = __builtin_amdgcn_mfma_f32_16x16x32_bf16(ca[ft], sa, z4, 0, 0, 0); *(LAS u32x2*)(L + M_Q0 * MSZ + (16 * st + fr) * LST + (16 * ft + 4 * fq) * 2) = pk4(acc); } }
                else { LAS unsigned char* Tcur = (lv & 1) ? L + M_T0 * MSZ : L + M_T1 * MSZ; LAS unsigned char* Tnew = (lv & 1) ? L + M_T1 * MSZ : L + M_T0 * MSZ; const bf16x8 sa = rfa(Tcur, st, fr, fq); bf16x8 ca[2]; cfr2a(Pc, lane, ca);
#pragma unroll
                    for (int ft = 0; ft < 2; ++ft) { const int o = (16 * st + fr) * LST + (16 * ft + 4 * fq) * 2; const f32x4 acc = __builtin_amdgcn_mfma_f32_16x16x32_bf16(ca[ft], sa, up4(*(const LAS u32x2*)(Tcur + o)), 0, 0, 0); *(LAS u32x2*)(Tnew + o) = pk4(acc); } }
            } else
            if (w < 4) { if (lv < 5) { const Fr2 sf = rfr(Pc, st, fr, fq); Fr2 cf[4]; cfr4(Pc, lane, cf);
#pragma unroll
                for (int ft = 0; ft < 4; ++ft) { const f32x4 acc = mm2(cf[ft], sf, (f32x4){0.f, 0.f, 0.f, 0.f}); *(LAS u32x2*)(Pn + (16 * st + fr) * LST + (16 * ft + 4 * fq) * 2) = pk4(acc); } } }
            else if (lv == 0) { const Fr2 sf = rfr(L + M_MTAK * MSZ, st, fr, fq); Fr2 cf[4]; cfr4(L + M_VT * MSZ, lane, cf);
#pragma unroll
                for (int ft = 0; ft < 4; ++ft) { const f32x4 acc = mm2(cf[ft], sf, (f32x4){0.f, 0.f, 0.f, 0.f}); *(LAS u32x2*)(L + M_Q0 * MSZ + (16 * st + fr) * LST + (16 * ft + 4 * fq) * 2) = pk4(acc); } }
            else { LAS unsigned char* Tcur = (lv & 1) ? L + M_T0 * MSZ : L + M_T1 * MSZ; LAS unsigned char* Tnew = (lv & 1) ? L + M_T1 * MSZ : L + M_T0 * MSZ; const Fr2 sf = rfr(Tcur, st, fr, fq); Fr2 cf[4]; cfr4(Pc, lane, cf);
#pragma unroll
                for (int ft = 0; ft < 4; ++ft) { const int o = (16 * st + fr) * LST + (16 * ft + 4 * fq) * 2; const f32x4 acc = mm2(cf[ft], sf, up4(*(const LAS u32x2*)(Tcur + o))); *(LAS u32x2*)(Tnew + o) = pk4(acc); } }
            (void)Tc; (void)Tn;
            LDS_WAIT(); __syncthreads();
        }
        { const int st = w & 3; LAS unsigned char* X = L + ((w < 4) ? M_AT : M_Q0) * MSZ; LAS unsigned char* O = L + ((w < 4) ? M_P0 : M_T0) * MSZ;
          if (st < 2) { const bf16x8 sa = rfa(L + M_T1 * MSZ, st, fr, fq); bf16x8 ca[4]; cfr4a(X, lane, ca);
#pragma unroll
              for (int ft = 0; ft < 4; ++ft) { const f32x4 acc = __builtin_amdgcn_mfma_f32_16x16x32_bf16(ca[ft], sa, (f32x4){0.f, 0.f, 0.f, 0.f}, 0, 0, 0); *(LAS u32x2*)(O + (16 * st + fr) * LST + (16 * ft + 4 * fq) * 2) = pk4(acc); } }
          else { const Fr2 sf = rfr(L + M_T1 * MSZ, st, fr, fq); Fr2 cf[4]; cfr4(X, lane, cf);
#pragma unroll
              for (int ft = 0; ft < 4; ++ft) { const f32x4 acc = mm2(cf[ft], sf, (f32x4){0.f, 0.f, 0.f, 0.f}); *(LAS u32x2*)(O + (16 * st + fr) * LST + (16 * ft + 4 * fq) * 2) = pk4(acc); } } }
        LDS_WAIT(); __syncthreads();
        SA_CLAIM();
        { const int st = w & 3; const int y = 16 * st + fr; const size_t row = (size_t)tok_row(b, z, c, y), zr = (size_t)z * R + row;
          const Fr2 s1 = cfr(L + M_T0 * MSZ, st, lane), s2f = cfr(L + M_VT * MSZ, st, lane);
          if (w < 4) { const Fr2 sf = rfr(L + M_NTRB * MSZ, st, fr, fq); Fr2 ap[4]; cfr4(L + M_P0 * MSZ, lane, ap);
#pragma unroll
              for (int ft = 0; ft < 4; ++ft) { const f32x4 acc = mm2(ap[ft], sf, up4(*(const LAS u32x2*)(L + M_RT * MSZ + y * LST + (16 * ft + 4 * fq) * 2)));
                  *(u32x2*)(KD + zr * 1024 + h * 64 + 16 * ft + 4 * fq) = pk4(acc); }
#pragma unroll
              for (int ft = 0; ft < 4; ++ft) { f32x4 acc = mm2(rfr(L + M_NTRB * MSZ, ft, fr, fq), s1, (f32x4){0.f, 0.f, 0.f, 0.f}); acc = mm2(rfr(L + M_NTRK * MSZ, ft, fr, fq), s2f, acc);
                  *(u32x2*)(BD + zr * 1024 + h * 64 + 16 * ft + 4 * fq) = pk4(acc); } }
          else { const Fr2 sf = cfr(L + M_BT * MSZ, st, lane); const float g = gC[y]; Fr2 ap[4]; cfr4(L + M_P0 * MSZ, lane, ap);
#pragma unroll
              for (int ft = 0; ft < 4; ++ft) { f32x4 acc = mm2(ap[ft], sf, (f32x4){0.f, 0.f, 0.f, 0.f});
#pragma unroll
                  for (int e = 0; e < 4; ++e) acc[e] = g * (acc[e] + ((16 * ft + 4 * fq + e == y) ? 1.f : 0.f));
                  *(u32x2*)((bf16_t*)(WD + zr * 1024 + h * 64) + 16 * ft + 4 * fq) = pk4(acc); }
              Fr2 bt4[4], kt4[4]; cfr4(L + M_BT * MSZ, lane, bt4); cfr4(L + M_KT * MSZ, lane, kt4);
#pragma unroll
              for (int ft = 0; ft < 4; ++ft) { f32x4 acc = mm2(bt4[ft], s1, (f32x4){0.f, 0.f, 0.f, 0.f}); acc = mm2(kt4[ft], s2f, acc);
                  const f32x4 g4 = *(const LAS f32x4*)(gC + 16 * ft + 4 * fq);
                  *(u32x2*)((bf16_t*)(WD + zr * 1024 + h * 64) + 64 + 16 * ft + 4 * fq) = pk4(acc * g4); } }
        }
    }
    __syncthreads();
}
__device__ __forceinline__ void phase_scanB(const F& f0) {
    using namespace rk;
    const F f = refresh(f0);
    unsigned char* T = f.ws + WS_T; const unsigned char* WDb = (const unsigned char*)(T + T_WD); const unsigned char* KDb = (const unsigned char*)(T + T_KD); const unsigned char* BDb = (const unsigned char*)(T + T_BD);
    constexpr int NR = 5, SLOT = 24576, O_PHI = 0, O_RP = 8192, O_PSI = 16384, O_Y0 = 20480, NCH = 68;
    const int fr = f.lane & 15, fq = f.lane >> 4, w = f.wave;
    for (int task = f.vcu; task < NBATCH * RWH * 2 * 2; task += f.G) {
        const int ci = task >> 1, hq = task & 1, b = ci >> 5, h = (ci >> 1) & 15, z = ci & 1, sgn = z ? -1 : 1;
#define SB_ROW0(c_) (b * TS + ((z == 0) ? 64 * (c_) : ((c_) < 4 ? CTXL - 1 - 64 * (c_) : TS + CTXL - 1 - 64 * (c_))))
        int loff[4]; const int lr8 = f.lane >> 3, gch = ((f.lane & 7) ^ lr8) * 16;
#pragma unroll
        for (int k = 0; k < 4; ++k) { const int j = 4 * (w - 2) + k; int o;
            if (j < 8) o = sgn * (8 * j + lr8) * 4096 + gch; else if (j < 16) o = sgn * (8 * (j - 8) + lr8) * 2048 + gch;
            else if (j < 20) o = sgn * (32 * hq + 8 * (j - 16) + lr8) * 4096 + 128 + gch; else o = sgn * (32 * hq + 8 * (j - 20) + lr8) * 2048 + gch;
            loff[k] = o; }
#define SB_ISSUE(c_) do { const size_t zr0_ = (size_t)z * R + (size_t)SB_ROW0(c_); const unsigned char* wb_ = WDb + (zr0_ * 1024 + h * 64) * 4; const unsigned char* kb_ = KDb + (zr0_ * 1024 + h * 64) * 2; \
            const unsigned char* bb_ = BDb + (zr0_ * 1024 + h * 64) * 2; LAS unsigned char* sl_ = f.lds + ((c_) % NR) * SLOT; \
            _Pragma("unroll") for (int k = 0; k < 4; ++k) { const int j = 4 * (w - 2) + k; const unsigned char* gb_ = (j < 8) ? wb_ : (j < 16) ? kb_ : (j < 20) ? wb_ : bb_; \
                __builtin_amdgcn_global_load_lds((const unsigned*)(gb_ + loff[k]), (LAS unsigned*)(sl_ + j * 1024), 16, 0, 0); } } while (0)
        if (w >= 2) { SB_ISSUE(0); SB_ISSUE(1); SB_ISSUE(2); }
        const int q = 2 * hq + (w & 1), ri = 16 * (w & 1) + fr;
        unsigned char* Yb = (z == 0) ? (T + T_KK) : (T + T_MG);
        const int offY = sgn * fq * 4 * 2048 + fr * 2;
        f32x4 S[4];
#pragma unroll
        for (int mt = 0; mt < 4; ++mt) S[mt] = (f32x4){0.f, 0.f, 0.f, 0.f};
        for (int c = 0; c < NCH; ++c) {
            if (w >= 2) { if (c + 3 < NCH) { SB_ISSUE(c + 3); asm volatile("s_waitcnt vmcnt(12)" ::: "memory"); } else asm volatile("s_waitcnt vmcnt(0)" ::: "memory"); }
            asm volatile("s_waitcnt lgkmcnt(0)" ::: "memory"); __builtin_amdgcn_s_barrier(); asm volatile("" ::: "memory");
            if (w < 2) {
                const LAS unsigned char* sl = f.lds + (c % NR) * SLOT;
                bf16x8 sb[2];
#pragma unroll
                for (int ks = 0; ks < 2; ++ks) { u32x4 w4; w4.x = pk2(S[2 * ks][0], S[2 * ks][1]); w4.y = pk2(S[2 * ks][2], S[2 * ks][3]); w4.z = pk2(S[2 * ks + 1][0], S[2 * ks + 1][1]); w4.w = pk2(S[2 * ks + 1][2], S[2 * ks + 1][3]); sb[ks] = __builtin_bit_cast(bf16x8, w4); }
                unsigned char* yb = Yb + ((size_t)SB_ROW0(c) * 1024 + h * 64 + 16 * q) * 2;
#pragma unroll
                for (int mt = 0; mt < 4; ++mt) {
                    const int r = 16 * mt + fr, sw = r & 7, chs = 2 * mt + (fq >> 1), sub = (fq & 1) * 8;
                    f32x4 ya = up4(*(const LAS u32x2*)(sl + O_Y0 + ri * 128 + ((chs ^ (ri & 7)) * 16) + sub)), sa = up4(*(const LAS u32x2*)(sl + O_PSI + ri * 128 + ((chs ^ (ri & 7)) * 16) + sub));
#pragma unroll
                    for (int ks = 0; ks < 2; ++ks) { const int c0 = 4 * ks + (fq >> 1), c1 = c0 + 2;
                        const u32x2 r0 = *(const LAS u32x2*)(sl + O_RP + r * 128 + ((c0 ^ sw) * 16) + sub), r1 = *(const LAS u32x2*)(sl + O_RP + r * 128 + ((c1 ^ sw) * 16) + sub);
                        const u32x2 p0 = *(const LAS u32x2*)(sl + O_PHI + r * 128 + ((c0 ^ sw) * 16) + sub), p1 = *(const LAS u32x2*)(sl + O_PHI + r * 128 + ((c1 ^ sw) * 16) + sub);
                        u32x4 ar; ar.x = r0.x; ar.y = r0.y; ar.z = r1.x; ar.w = r1.y; u32x4 ap; ap.x = p0.x; ap.y = p0.y; ap.z = p1.x; ap.w = p1.y;
                        ya = __builtin_amdgcn_mfma_f32_16x16x32_bf16(__builtin_bit_cast(bf16x8, ar), sb[ks], ya, 0, 0, 0);
                        sa = __builtin_amdgcn_mfma_f32_16x16x32_bf16(__builtin_bit_cast(bf16x8, ap), sb[ks], sa, 0, 0, 0); }
#pragma unroll
                    for (int e = 0; e < 4; ++e) *(bf16_t*)(yb + (long)sgn * (16 * mt + e) * 2048 + offY) = f2bf(ya[e]);
                    S[mt] = sa;
                }
            }
        }
        asm volatile("s_waitcnt lgkmcnt(0)" ::: "memory"); __builtin_amdgcn_s_barrier(); asm volatile("" ::: "memory");
#undef SB_ISSUE
#undef SB_ROW0
    }
}
__device__ __forceinline__ void phase_rwkv_post(const F& f0, int l, bool keep) {
    const F f = refresh(f0);
    const ArgView& a = *f.a; unsigned char* T = f.ws + WS_T; const unsigned char* wb = f.ws + WS_WB + (size_t)l * WB_BYTES;
    const bf16_t* Y = (const bf16_t*)(T + T_KK); const bf16_t* Y1 = (const bf16_t*)(T + T_MG); const bf16_t* VV = (const bf16_t*)(T + T_VV); const float* BON = (const float*)(f.ws + WS_BON); bf16_t* RWo = (bf16_t*)(T + T_RW);
    const int cb = f.vcu & 15, rg = f.vcu >> 4, ngrp = f.G >> 4;
    for (int i = f.tid; i < 64 * 40; i += NTHR) { const int n = i / 40, c = i % 40; *(LAS u32x4*)(f.lds + n * lr::P320 + c * 16) = *(const u32x4*)((const bf16_t*)(wb + WB_G2) + (size_t)(cb * 64 + n) * 320 + c * 8); }
    LDS_WAIT(); __syncthreads();
    f32x4 lw4[4], lb4[4];
    { const int fq0 = f.lane >> 4;
#pragma unroll
      for (int nt = 0; nt < 4; ++nt) { lw4[nt] = *(const f32x4*)(a.in[I_LNW] + (size_t)l * 1024 + cb * 64 + 16 * nt + 4 * fq0); lb4[nt] = *(const f32x4*)(a.in[I_LNB] + (size_t)l * 1024 + cb * 64 + 16 * nt + 4 * fq0); } }
    for (int t = rg + ngrp * f.wave; t < R / 16; t += ngrp * NWAVES) {
        if (!keep && (t % (TS / 16)) < CTXL / 16) continue;
        int lane = f.lane; asm volatile("" : "+v"(lane));
        const int fr = lane & 15, fq = lane >> 4; const size_t row = (size_t)(t * 16 + fr), eo = row * 1024 + cb * 64 + 4 * fq;
        const bf16_t* LAp = (const bf16_t*)(T + T_LA) + row * LA_W + 256 + 8 * fq;
        bf16x8 afa[10]; u32x2 y0[4], y1[4], v4[4];
#pragma unroll
        for (int i = 0; i < 10; ++i) afa[i] = *(const bf16x8*)(LAp + 32 * i);
#pragma unroll
        for (int nt = 0; nt < 4; ++nt) { y0[nt] = *(const u32x2*)(Y + eo + 16 * nt); y1[nt] = *(const u32x2*)(Y1 + eo + 16 * nt); v4[nt] = *(const u32x2*)(VV + eo + 16 * nt); }
        const float bonus = BON[row * 16 + cb] + BON[((size_t)R + row) * 16 + cb];
        f32x4 gg[4], yy[4]; float s1 = 0.f;
#pragma unroll
        for (int nt = 0; nt < 4; ++nt) { f32x4 acc = (f32x4){0.f, 0.f, 0.f, 0.f};
#pragma unroll
            for (int ks = 0; ks < 10; ++ks) acc = __builtin_amdgcn_mfma_f32_16x16x32_bf16(*(const LAS bf16x8*)(f.lds + (16 * nt + fr) * lr::P320 + (32 * ks + 8 * fq) * 2), afa[ks], acc, 0, 0, 0);
            gg[nt] = acc; yy[nt] = rk::up4(y0[nt]) + rk::up4(y1[nt]); s1 += (yy[nt][0] + yy[nt][1]) + (yy[nt][2] + yy[nt][3]); }
        s1 += __shfl_xor(s1, 16); s1 += __shfl_xor(s1, 32); const float mean = s1 * (1.0f / 64.0f); float q2 = 0.f;
#pragma unroll
        for (int nt = 0; nt < 4; ++nt) { const f32x4 d = yy[nt] - mean; q2 += (d[0] * d[0] + d[1] * d[1]) + (d[2] * d[2] + d[3] * d[3]); }
        q2 += __shfl_xor(q2, 16); q2 += __shfl_xor(q2, 32); const float rstd = rsqrtf(q2 * (1.0f / 64.0f) + GN_EPS);
#pragma unroll
        for (int nt = 0; nt < 4; ++nt) { const f32x4 yn = (yy[nt] - mean) * rstd * lw4[nt] + lb4[nt]; const f32x4 o = (yn + rk::up4(v4[nt]) * bonus) * gg[nt]; *(u32x2*)(RWo + eo + 16 * nt) = rk::pk4(o); }
    }
}

struct SchedMerge { static constexpr bool GATHER = false; const char *A0, *B0; int G, c, nM; bool keep;
    __device__ __forceinline__ bool next(int i, pg8::Unit& u) const { const int tile = (i / 3) * G + c, seg = i % 3; if (tile >= nM * 8) return false; int pm, pn; pg8::tile_of(tile, nM, 8, pm, pn); pm = panel_of(pm, keep);
        u.A = A0 + (size_t)seg * ((size_t)R * 1024 * 2) + (size_t)pm * 256 * 1024 * 2; u.B = B0 + (size_t)seg * ((size_t)2048 * 1024 * 2) + (size_t)pn * 256 * 1024 * 2; u.pm = pm; u.pn = pn; u.aux = seg; return true; }
};
struct EpiMerge { const bf16_t* PG; bf16_t* MG;
    __device__ __forceinline__ bool operator()(pg8::Acc& acc, const pg8::Unit& u, int wr, int wc, int fr, int fq) const {
        asm volatile("" : "+v"(fr), "+v"(fq));
        const int seg = u.aux;
        const bf16_t* ta = PG + (((size_t)u.pm * 24 + (seg * 8 + u.pn)) * 8 + (wr * 4 + wc)) * (16 * 64 * 8) + (fq * 16 + fr) * 8;
        const bf16_t* tb = ta + (size_t)8 * 8 * (16 * 64 * 8);
#pragma unroll
        for (int hb = 0; hb < 4; ++hb) { const int ai = hb >> 1, q0 = (hb & 1) * 4;
            u32x4 ga[4], gb[4];
#pragma unroll
            for (int q = 0; q < 4; ++q) ga[q] = *(const u32x4*)(ta + (ai * 8 + q0 + q) * (64 * 8));
            if (seg < 2) {
#pragma unroll
                for (int q = 0; q < 4; ++q) gb[q] = *(const u32x4*)(tb + (ai * 8 + q0 + q) * (64 * 8)); }
            asm volatile("" ::: "memory");
#pragma unroll
            for (int q = 0; q < 4; ++q) { const int m = (q0 + q) >> 1, bj = (q0 + q) & 1; float sa[8], mlt[8];
                sa[0] = bflo(ga[q].x); sa[1] = bfhi(ga[q].x); sa[2] = bflo(ga[q].y); sa[3] = bfhi(ga[q].y); sa[4] = bflo(ga[q].z); sa[5] = bfhi(ga[q].z); sa[6] = bflo(ga[q].w); sa[7] = bfhi(ga[q].w);
                if (seg < 2) { float sb[8]; sb[0] = bflo(gb[q].x); sb[1] = bfhi(gb[q].x); sb[2] = bflo(gb[q].y); sb[3] = bfhi(gb[q].y); sb[4] = bflo(gb[q].z); sb[5] = bfhi(gb[q].z); sb[6] = bflo(gb[q].w); sb[7] = bfhi(gb[q].w);
#pragma unroll
                    for (int j = 0; j < 8; ++j) mlt[j] = sb[j] * __builtin_amdgcn_rcpf(sa[j]); }
                else {
#pragma unroll
                    for (int j = 0; j < 8; ++j) mlt[j] = __builtin_amdgcn_rcpf(sa[j]); }
                acc[ai][bj][m][0] *= (f32x4){mlt[0], mlt[1], mlt[2], mlt[3]}; acc[ai][bj][m][1] *= (f32x4){mlt[4], mlt[5], mlt[6], mlt[7]}; }
            if (seg == 2) {
#pragma unroll
                for (int q = 0; q < 4; ++q) { const int m = (q0 + q) >> 1, bj = (q0 + q) & 1; pg8::st8(MG + (size_t)(u.pm * 256 + 128 * ai + 64 * wr + 16 * m + fr) * D + u.pn * 256 + 128 * bj + 32 * wc + 8 * fq, acc[ai][bj][m][0], acc[ai][bj][m][1]); } }
        }
        return seg < 2; }
};

__device__ __forceinline__ unsigned char* moe_w(const F& f, int l) { return l == 0 ? f.ws + WS_T + T_WGU : f.ws + WS_MOE1; }
__device__ __forceinline__ void cvt_moe(const F& f, int l, int vgw, int vngw, int parts = 15) {
    const ArgView& a = *f.a; int off = 0; unsigned char* wgu = moe_w(f, l); unsigned char* wdn = wgu + MOE_WGU_BYTES;
    if (parts & 1) cvt_T<2>(f, a.in[I_WEG] + (size_t)l * NE * 2048 * 1024, NE, 2048, 1024, (bf16_t*)wgu, 2048, off, vgw, vngw);
    if (parts & 2) cvt_T<3>(f, a.in[I_WEU] + (size_t)l * NE * 2048 * 1024, NE / 2, 2048, 1024, (bf16_t*)wgu, 2048, off, vgw, vngw);
    if (parts & 8) cvt_T<3>(f, a.in[I_WEU] + ((size_t)l * NE + NE / 2) * 2048 * 1024, NE / 2, 2048, 1024, (bf16_t*)wgu + (size_t)(NE / 2) * 2048 * 2048, 2048, off, vgw, vngw);
    if (parts & 4) cvt_T<0>(f, a.in[I_WED] + (size_t)l * NE * 1024 * 2048, NE, 1024, 2048, (bf16_t*)wdn, 2048, off, vgw, vngw);
}
__device__ __forceinline__ int tail_rank(int tiles, int G, int& n_idle) { const int extra = tiles % G; n_idle = G - extra; return (extra > 0 && (int)blockIdx.x >= extra) ? (int)blockIdx.x - extra : -1; }
__device__ __forceinline__ void phase_resid1(const F& f0, int l, bool keep) {
    const F f = refresh(f0);
    const ArgView& a = *f.a; unsigned char* T = f.ws + WS_T; bf16_t* XS = (bf16_t*)(f.ws + WS_XS); bf16_t* H = (bf16_t*)(f.ws + WS_H); const bf16_t* MX = (const bf16_t*)(T + T_MX); float* AFF = (float*)(f.ws + WS_AFF);
    LAS float* WR = (LAS float*)f.lds;
    { const float* wr = a.in[I_WRT] + (size_t)l * 2048 * 16;
      for (int i = f.tid; i < 2048 * 4; i += NTHR) { const int k = i >> 2, q = i & 3; const f32x4 w = *(const f32x4*)(wr + k * 16 + q * 4);
          WR[(4 * q + 0) * 2048 + k] = w.x; WR[(4 * q + 1) * 2048 + k] = w.y; WR[(4 * q + 2) * 2048 + k] = w.z; WR[(4 * q + 3) * 2048 + k] = w.w; } }
    __syncthreads();
    const int nrows = keep ? R : NBATCH * SEQ;
    for (int idx = f.gw; idx < nrows; idx += f.NGW) { const int row = row_of(idx, keep);
        f32x4 mx[8], xs[8], y[8]; row_ld_bf16(MX + (size_t)row * D, mx, f.lane);
        if (l == 0) { const int b = row / TS, t = row % TS; row_ld_f32((t < CTXL) ? a.in[I_CTX] + ((size_t)b * CTXL + t) * D : a.in[I_X] + ((size_t)b * SEQ + (t - CTXL)) * D, xs, f.lane); } else row_ld_bf16(XS + (size_t)row * D, xs, f.lane);
        { f32x4 gv[8], nv[8]; const float* np0 = a.in[I_NPOST] + (size_t)(l * 2 + 0) * D; const float* g2 = mod_vec(f, l, row, 2);
#pragma unroll
          for (int j = 0; j < 8; ++j) { const int e = (j * 64 + f.lane) * 4; gv[j] = *(const f32x4*)(g2 + e); nv[j] = *(const f32x4*)(np0 + e); }
          asm volatile("" ::: "memory");
          const float rstd = row_rstd(mx);
#pragma unroll
          for (int j = 0; j < 8; ++j) xs[j] = xs[j] + gv[j] * (mx[j] * rstd * nv[j]); }
        { f32x4 gg[8], sh[8], sc[8]; const float* gp = a.in[I_NPRE] + (size_t)(l * 2 + 1) * D; const float* shp = mod_vec(f, l, row, 3); const float* scp = mod_vec(f, l, row, 4);
#pragma unroll
          for (int j = 0; j < 8; ++j) { const int e = (j * 64 + f.lane) * 4; gg[j] = *(const f32x4*)(gp + e); sh[j] = *(const f32x4*)(shp + e); sc[j] = *(const f32x4*)(scp + e); }
          asm volatile("" ::: "memory");
          row_st_bf16(XS + (size_t)row * D, xs, f.lane);
          const float rstd2 = row_rstd(xs);
#pragma unroll
          for (int j = 0; j < 8; ++j) y[j] = xs[j] * rstd2 * gg[j] * (sc[j] + 1.0f) + sh[j]; }
        row_st_bf16(H + (size_t)row * D, y, f.lane);
        float lg[16];
#pragma unroll
        for (int ex = 0; ex < 16; ++ex) { float s = 0.f;
#pragma unroll
            for (int j = 0; j < 8; ++j) { const f32x4 w = *(const LAS f32x4*)(WR + ex * 2048 + (j * 64 + f.lane) * 4); s += (y[j].x * w.x + y[j].y * w.y) + (y[j].z * w.z + y[j].w * w.w); }
            lg[ex] = wave_sum(s); }
        float mxl = lg[0];
#pragma unroll
        for (int ex = 1; ex < 16; ++ex) mxl = fmaxf(mxl, lg[ex]);
        float den = 0.f;
#pragma unroll
        for (int ex = 0; ex < 16; ++ex) { lg[ex] = __expf(lg[ex] - mxl); den += lg[ex]; }
        const float rd = 1.0f / den; float mine = 0.f;
#pragma unroll
        for (int ex = 0; ex < 16; ++ex) mine = (f.lane == ex) ? lg[ex] * rd : mine;
        if (f.lane < 16) AFF[(size_t)row * 16 + f.lane] = mine;
    }
}

__device__ __forceinline__ void phase_route(const F& f0, bool keep) {
    const F f = refresh(f0);
    const float* AFF = (const float*)(f.ws + WS_AFF); int* TOKSLOT = (int*)(f.ws + WS_TOKSLOT); int* SLOTROW = (int*)(f.ws + WS_SLOTROW);
    LAS unsigned* hist = (LAS unsigned*)f.lds; LAS unsigned* ctl = hist + 256; LAS unsigned* wsum = hist + 320;
    const int nl = keep ? 128 : 64;
    for (int li = f.vcu; li < nl; li += f.G) {
        int b, e, n, cap, row0, slot0;
        if (li < 64) { b = li >> 4; e = li & 15; n = SEQ; cap = CAP_L; row0 = b * TS + CTXL; slot0 = e * ESLOTS + b * CAP_L; }
        else { const int lc = li - 64; b = lc >> 4; e = lc & 15; n = CTXL; cap = CAP_C; row0 = b * TS; slot0 = e * ESLOTS + NBATCH * CAP_L + b * CAP_C; }
        unsigned key[8]; const int i0 = f.tid * 8;
#pragma unroll
        for (int j = 0; j < 8; ++j) key[j] = (i0 + j < n) ? __float_as_uint(AFF[(size_t)(row0 + i0 + j) * 16 + e]) : 0u;
        unsigned prefix = 0u, remaining = (unsigned)cap;
#pragma unroll
        for (int pass = 0; pass < 4; ++pass) { const int sh = 24 - 8 * pass; const unsigned himask = pass == 0 ? 0u : (0xffffffffu << (sh + 8));
            if (f.tid < 256) hist[f.tid] = 0u;
            __syncthreads();
#pragma unroll
            for (int j = 0; j < 8; ++j) if (i0 + j < n && (key[j] & himask) == prefix) atomicAdd((unsigned*)&hist[(key[j] >> sh) & 255u], 1u);
            __syncthreads();
            if (f.tid < 64) {
                unsigned h4[4]; unsigned s = 0u;
#pragma unroll
                for (int q = 0; q < 4; ++q) { h4[q] = hist[f.tid * 4 + q]; s += h4[q]; }
                unsigned suf = s;
#pragma unroll
                for (int o = 1; o < 64; o <<= 1) { const unsigned t = __shfl_down(suf, o); if (f.lane + o < 64) suf += t; }
                unsigned acc = suf - s; int found = -1; unsigned rem_new = 0u;
#pragma unroll
                for (int q = 3; q >= 0; --q) { if (found < 0 && acc < remaining && acc + h4[q] >= remaining) { found = f.tid * 4 + q; rem_new = remaining - acc; } acc += h4[q]; }
                if (found >= 0) { ctl[0] = prefix | ((unsigned)found << sh); ctl[1] = rem_new; }
            }
            __syncthreads();
            prefix = ctl[0]; remaining = ctl[1];
            __syncthreads();
        }
        unsigned gt = 0u, eq = 0u;
#pragma unroll
        for (int j = 0; j < 8; ++j) { if (i0 + j < n) { gt += key[j] > prefix ? 1u : 0u; eq += key[j] == prefix ? 1u : 0u; } }
        unsigned pg = gt, pe = eq;
#pragma unroll
        for (int o = 1; o < 64; o <<= 1) { const unsigned tg = __shfl_up(pg, o), te = __shfl_up(pe, o); if (f.lane >= o) { pg += tg; pe += te; } }
        if (f.lane == 63) { wsum[f.wave] = pg; wsum[8 + f.wave] = pe; }
        __syncthreads();
        unsigned bg = 0u, be = 0u;
#pragma unroll
        for (int w2 = 0; w2 < 8; ++w2) { if (w2 < f.wave) { bg += wsum[w2]; be += wsum[8 + w2]; } }
        unsigned cg = bg + pg - gt, ce = be + pe - eq;
#pragma unroll
        for (int j = 0; j < 8; ++j) { if (i0 + j < n) { const bool isg = key[j] > prefix, ise = key[j] == prefix; const bool sel = isg || (ise && ce < remaining);
                const unsigned taken_eq = ce < remaining ? ce : remaining;
                const int slot = slot0 + (int)(cg + taken_eq); const int row = row0 + i0 + j;
                TOKSLOT[(size_t)row * 16 + e] = sel ? slot : -1; if (sel) SLOTROW[slot] = row;
                cg += isg ? 1u : 0u; ce += ise ? 1u : 0u; } }
        __syncthreads();
    }
}
__device__ __forceinline__ void phase_gather(const F& f0, bool keep) {
    const F f = refresh(f0);
    unsigned char* T = f.ws + WS_T; const int* SLOTROW = (const int*)(f.ws + WS_SLOTROW); const bf16_t* H = (const bf16_t*)(f.ws + WS_H); bf16_t* XG = (bf16_t*)(T + T_XG);
    const int per = keep ? (NBATCH * CAP_L + NBATCH * CAP_C) : NBATCH * CAP_L;
    for (int i = f.gw; i < NE * per; i += f.NGW) { const int slot = (i / per) * ESLOTS + (i % per); const int row = SLOTROW[slot];
        const u32x4* src = (const u32x4*)(H + (size_t)row * D); u32x4* dst = (u32x4*)(XG + (size_t)slot * D);
#pragma unroll
        for (int j = 0; j < 4; ++j) dst[f.lane + 64 * j] = src[f.lane + 64 * j]; }
}

template <bool GA> struct SchedMoeT { static constexpr bool GATHER = GA; const char* A; const char* B; const int* idx; size_t a_row_bytes, b_tile, b_exp; int G, c, nrt;
    __device__ __forceinline__ bool next(int i, pg8::Unit& u) const { const int L = i * G + c; if (L >= NE * nrt * 8) return false; const int e = L / (nrt * 8), rem = L % (nrt * 8), rt = rem >> 3, pn = rem & 7;
        u.pm = e * 9 + rt; u.pn = pn; u.aux = pn * 256; u.A = GA ? A : A + (size_t)u.pm * 256 * a_row_bytes; u.gidx = idx + (size_t)u.pm * 256; u.B = B + (size_t)e * b_exp + (size_t)pn * b_tile; return true; }
};
struct EpiSilu { bf16_t* HID;
    __device__ __forceinline__ bool operator()(pg8::Acc& acc, const pg8::Unit& u, int wr, int wc, int fr, int fq) const {
        asm volatile("" : "+v"(fr), "+v"(fq));
#pragma unroll
        for (int ai = 0; ai < 2; ++ai)
#pragma unroll
            for (int m = 0; m < 4; ++m) { f32x4 o[2];
#pragma unroll
                for (int n = 0; n < 2; ++n)
#pragma unroll
                    for (int j = 0; j < 4; ++j) { const float g = acc[ai][0][m][n][j]; o[n][j] = g / (1.0f + __expf(-g)) * acc[ai][1][m][n][j]; }
                pg8::st8(HID + (size_t)(u.pm * 256 + 128 * ai + 64 * wr + 16 * m + fr) * FF + u.pn * 128 + 32 * wc + 8 * fq, o[0], o[1]); }
        return false; }
};

__device__ __forceinline__ void phase_resid2(const F& f0, int l, bool keep) {
    const F f = refresh(f0);
    const ArgView& a = *f.a; unsigned char* T = f.ws + WS_T; bf16_t* XS = (bf16_t*)(f.ws + WS_XS); const bf16_t* Y = (const bf16_t*)(T + T_Y); const float* AFF = (const float*)(f.ws + WS_AFF); const int* TOKSLOT = (const int*)(f.ws + WS_TOKSLOT);
    bf16_t* H = (bf16_t*)(f.ws + WS_H);
    const int nrows = keep ? R : NBATCH * SEQ;
    for (int idx = f.gw; idx < nrows; idx += f.NGW) { const int row = row_of(idx, keep);
        const int myslot = (f.lane < 16) ? TOKSLOT[(size_t)row * 16 + f.lane] : -1; const float myaff = (f.lane < 16) ? AFF[(size_t)row * 16 + f.lane] : 0.f;
        unsigned long long mask = __ballot(myslot >= 0);
        f32x4 acc[8], xs[8];
        row_ld_bf16(XS + (size_t)row * D, xs, f.lane);
#pragma unroll
        for (int j = 0; j < 8; ++j) acc[j] = (f32x4){0.f, 0.f, 0.f, 0.f};
        while (mask) {
            const int e0 = __builtin_ctzll(mask); mask &= mask - 1; const int e1 = mask ? __builtin_ctzll(mask) : e0; const bool two = mask != 0ull; mask &= mask - 1;
            const int s0 = __builtin_amdgcn_readlane(myslot, e0), s1 = __builtin_amdgcn_readlane(myslot, e1);
            const float a0 = __uint_as_float(__builtin_amdgcn_readlane(__float_as_uint(myaff), e0)), a1 = two ? __uint_as_float(__builtin_amdgcn_readlane(__float_as_uint(myaff), e1)) : 0.f;
            f32x4 y0[8], y1[8]; row_ld_bf16(Y + (size_t)s0 * D, y0, f.lane); row_ld_bf16(Y + (size_t)s1 * D, y1, f.lane);
#pragma unroll
            for (int j = 0; j < 8; ++j) acc[j] += y0[j] * a0 + y1[j] * a1; }
        const float rstd = row_rstd(acc); const float* np1 = a.in[I_NPOST] + (size_t)(l * 2 + 1) * D; const float* g5 = mod_vec(f, l, row, 5);
        { f32x4 gv[8], nv[8];
#pragma unroll
          for (int j = 0; j < 8; ++j) { const int e = (j * 64 + f.lane) * 4; gv[j] = *(const f32x4*)(g5 + e); nv[j] = *(const f32x4*)(np1 + e); }
#pragma unroll
          for (int j = 0; j < 8; ++j) xs[j] = xs[j] + gv[j] * (acc[j] * rstd * nv[j]); }
        if (l == DEPTH - 1) { const int b = row / TS, t = row % TS; float* dst = a.out + ((size_t)b * SEQ + (t - CTXL)) * D;
#pragma unroll
            for (int j = 0; j < 8; ++j) *(f32x4*)(dst + (j * 64 + f.lane) * 4) = xs[j]; }
        else row_st_bf16(XS + (size_t)row * D, xs, f.lane);
        if (l < DEPTH - 1) {
            const float rstd2 = row_rstd(xs); f32x4 y[8];
            row_modnorm(xs, rstd2, a.in[I_NPRE] + (size_t)((l + 1) * 2 + 0) * D, mod_vec(f, l + 1, row, 0), mod_vec(f, l + 1, row, 1), y, f.lane);
            row_st_bf16(H + (size_t)row * D, y, f.lane); }
    }
}

constexpr int LDS_BYTES = 147456, MISC_OFF = 147456 - 64;
constexpr int NPH_LAYER = 15, NPHASES = 1 + DEPTH * NPH_LAYER;
__global__ void __launch_bounds__(NTHR, 2) mega(Args args) {
    extern __shared__ __attribute__((aligned(16))) unsigned char lds_raw[];
    ArgView av; av.out = args.out;
    F f; f.lds = (LAS unsigned char*)lds_raw; f.a = &av; f.ws = args.ws;
    f.tid = threadIdx.x; f.lane = f.tid & 63; f.wave = __builtin_amdgcn_readfirstlane(f.tid >> 6);
    f.G = gridDim.x; { const int bx = blockIdx.x; f.vcu = (f.G % 8 == 0) ? (bx % 8) * (f.G / 8) + bx / 8 : bx; }
    f.gw = f.vcu * NWAVES + f.wave; f.NGW = f.G * NWAVES;
    volatile LAS unsigned* MISC = (volatile LAS unsigned*)(f.lds + MISC_OFF);
    if (f.tid < 16) MISC[f.tid] = 0u;
    __syncthreads();
    const int lo = args.ph_lo, hi = args.ph_hi;
    unsigned* barw = (unsigned*)(f.ws + WS_CTL) + CW_BAR;
    XcdBarrier bar; bar.bar = barw; bar.x = 0; bar.st = nullptr;
    if (hi - lo > 1) bar = xcd_barrier_post(barw, MISC);
#ifndef PH_MASK
#define PH_MASK 0xFFFFFFFFu
#endif
#define PHE(j) ((PH_MASK >> (j)) & 1u)
#ifndef REP_MASK
#define REP_MASK 0u
#endif
#define REPS(j) (1 + (int)((REP_MASK >> (j)) & 1u))
#define IN(k) (lo <= (k) && (k) < hi)
#define SEAM(k) do { if (IN(k) && IN((k) + 1)) xcd_barrier(bar); } while (0)
    unsigned char* T = f.ws + WS_T;
    if (PHE(0) && IN(0)) for (int rep_ = 0; rep_ < REPS(0); ++rep_) { if (rep_) xcd_barrier(bar); phase_prologue(f); }
    SEAM(0);
    for (int l = 0; l < DEPTH; ++l) {
        const int pb = 1 + l * NPH_LAYER; const bool keep = l < DEPTH - 1;
        const unsigned char* wb = f.ws + WS_WB + (size_t)l * WB_BYTES;
        if (l == 0) { if (PHE(1) && IN(pb + 0)) for (int rep_ = 0; rep_ < REPS(1); ++rep_) { if (rep_) xcd_barrier(bar); phase_norm1(f, l); }
        SEAM(pb + 0); }
        if (PHE(2) && IN(pb + 1)) for (int rep_ = 0; rep_ < REPS(2); ++rep_) { if (rep_) xcd_barrier(bar);
            SchedP S{(const char*)(f.ws + WS_H), (const char*)(wb + WB_WIN), f.G, (int)blockIdx.x, keep};
            EpiP E{(bf16_t*)(T + T_PA), (bf16_t*)(T + T_PG)};
            { const F g = refresh(f); pg8::gemm_phase(g.lds, pg8::Desc{2048, 2048, 2048}, S, E, g.tid); }
            if (l == 0 && rep_ == 0) { int n_idle; const int rk_ = tail_rank((R / 256) * NP_TILES, f.G, n_idle); __syncthreads();
                if (rk_ >= 0) { const F g = refresh(f); cvt_wb(g, 1, rk_ * NWAVES + g.wave, n_idle * NWAVES); }
                else if (((R / 256) * NP_TILES) % f.G == 0) { const F g = refresh(f); cvt_wb(g, 1, g.gw, g.NGW); } }
            if (l == 1 && rep_ == 0) { int n_idle; const int rk_ = tail_rank(NBATCH * 16 * NP_TILES + NBATCH * 15, f.G, n_idle); __syncthreads();
                if (rk_ >= 0) { const F g = refresh(f); cvt_moe(g, 1, rk_ * NWAVES + g.wave, n_idle * NWAVES, 10); }
                else if ((NBATCH * 16 * NP_TILES + NBATCH * 15) % f.G == 0) { const F g = refresh(f); cvt_moe(g, 1, g.gw, g.NGW, 10); } }
        }
        SEAM(pb + 1);
        if (PHE(3) && IN(pb + 2)) for (int rep_ = 0; rep_ < REPS(3); ++rep_) { if (rep_) xcd_barrier(bar); phase_prep_rows(f, l); }
        SEAM(pb + 2);
        if (PHE(5) && IN(pb + 4)) for (int rep_ = 0; rep_ < REPS(5); ++rep_) { if (rep_) xcd_barrier(bar);
#ifndef MIX_MASK
#define MIX_MASK 7
#endif
            const bool scan_first = (((int)blockIdx.x >> 3) & 1) != 0;
            for (int step = 0; step < 2; ++step) {
                if ((step == 0) == scan_first) { if ((MIX_MASK & 4) && rep_ == 0) phase_scanA(f, l); }
                else {
                    if (MIX_MASK & 1) phase_attn(f, keep);
                    __syncthreads();
                    if (MIX_MASK & 2) { SchedPool S{(const char*)(f.ws + WS_PL), (const char*)(wb + WB_WPG), f.G, (int)blockIdx.x, keep ? R / 256 : NBATCH * 16, keep};
                      EpiStore E{(bf16_t*)(T + T_PO), 1024, f.a->in[I_PSC] + (size_t)l * 1024};
                      { const F g = refresh(f); pg8::gemm_phase(g.lds, pg8::Desc{256, 1024, 256}, S, E, g.tid); } }
                }
                __syncthreads();
            }
        }
        SEAM(pb + 4);
        if (PHE(6) && IN(pb + 5)) for (int rep_ = 0; rep_ < REPS(6); ++rep_) { if (rep_) xcd_barrier(bar); phase_scanB(f); }
        SEAM(pb + 5);
        if (PHE(7) && IN(pb + 6)) for (int rep_ = 0; rep_ < REPS(7); ++rep_) { if (rep_) xcd_barrier(bar); phase_rwkv_post(f, l, keep); }
        SEAM(pb + 6);
        if (PHE(8) && IN(pb + 7)) for (int rep_ = 0; rep_ < REPS(8); ++rep_) { if (rep_) xcd_barrier(bar);
            SchedMerge S{(const char*)(T + T_AT), (const char*)(wb + WB_WA), f.G, (int)blockIdx.x, keep ? R / 256 : NBATCH * 16, keep};
            EpiMerge E{(const bf16_t*)(T + T_PG), (bf16_t*)(T + T_MG)};
            { const F g = refresh(f); pg8::gemm_phase(g.lds, pg8::Desc{1024, 1024, 1024}, S, E, g.tid); }
            if (keep && rep_ == 0) {
                int n_idle; const int rk_ = tail_rank((R / 256) * 8, f.G, n_idle); __syncthreads();
                if (rk_ >= 0) { const F g = refresh(f); cvt_moe(g, l, rk_ * NWAVES + g.wave, n_idle * NWAVES, 3); }
                else if (((R / 256) * 8) % f.G == 0) { const F g = refresh(f); cvt_moe(g, l, g.gw, g.NGW, 3); } }
        }
        SEAM(pb + 7);
        if (PHE(9) && IN(pb + 8)) for (int rep_ = 0; rep_ < REPS(9); ++rep_) { if (rep_) xcd_barrier(bar);
            SchedTiles S{(const char*)(T + T_MG), (const char*)(wb + WB_WOUT), (size_t)256 * 2048 * 2, (size_t)256 * 2048 * 2, f.G, (int)blockIdx.x, keep ? R / 256 : NBATCH * 16, 8, keep};
            EpiStore E{(bf16_t*)(T + T_MX), D, nullptr};
            { const F g = refresh(f); pg8::gemm_phase(g.lds, pg8::Desc{2048, 2048, 2048}, S, E, g.tid); }
            if (keep && rep_ == 0) { int n_idle; const int rk_ = tail_rank((R / 256) * 8, f.G, n_idle); __syncthreads();
                if (rk_ >= 0) { const F g = refresh(f); cvt_moe(g, l, rk_ * NWAVES + g.wave, n_idle * NWAVES, 12); }
                else if (((R / 256) * 8) % f.G == 0) { const F g = refresh(f); cvt_moe(g, l, g.gw, g.NGW, 12); } }
        }
        SEAM(pb + 8);
        if (PHE(10) && IN(pb + 9)) for (int rep_ = 0; rep_ < REPS(10); ++rep_) { if (rep_) xcd_barrier(bar); phase_resid1(f, l, keep); }
        SEAM(pb + 9);
        if (PHE(11) && IN(pb + 10)) for (int rep_ = 0; rep_ < REPS(11); ++rep_) { if (rep_) xcd_barrier(bar); phase_route(f, keep); }
        SEAM(pb + 10);
        if (PHE(13) && IN(pb + 12)) for (int rep_ = 0; rep_ < REPS(13); ++rep_) { if (rep_) xcd_barrier(bar);
            SchedMoeT<true> S{(const char*)(f.ws + WS_H), (const char*)moe_w(f, l), (const int*)(f.ws + WS_SLOTROW), (size_t)D * 2, (size_t)256 * 2048 * 2, (size_t)2048 * 2048 * 2, f.G, (int)blockIdx.x, keep ? 9 : 8};
            EpiSilu E{(bf16_t*)(T + T_HID)};
            { const F g = refresh(f); pg8::gemm_phase(g.lds, pg8::Desc{2048, 2048, 2048}, S, E, g.tid); }
            if (l == 0 && rep_ == 0) { int n_idle; const int rk_ = tail_rank(NE * 9 * 8, f.G, n_idle); __syncthreads();
                if (rk_ >= 0) { const F g = refresh(f); cvt_moe(g, 1, rk_ * NWAVES + g.wave, n_idle * NWAVES, 1); }
                else if ((NE * 9 * 8) % f.G == 0) { const F g = refresh(f); cvt_moe(g, 1, g.gw, g.NGW, 1); } }
        }
        SEAM(pb + 12);
        if (PHE(14) && IN(pb + 13)) for (int rep_ = 0; rep_ < REPS(14); ++rep_) { if (rep_) xcd_barrier(bar);
            SchedMoeT<false> S{(const char*)(T + T_HID), (const char*)(moe_w(f, l) + MOE_WGU_BYTES), (const int*)(f.ws + WS_SLOTROW), (size_t)FF * 2, (size_t)256 * 1024 * 2, (size_t)2048 * 1024 * 2, f.G, (int)blockIdx.x, keep ? 9 : 8};
            EpiStore E{(bf16_t*)(T + T_Y), D, nullptr};
            { const F g = refresh(f); pg8::gemm_phase(g.lds, pg8::Desc{1024, 1024, 1024}, S, E, g.tid); }
            if (l == 0 && rep_ == 0) { int n_idle; const int rk_ = tail_rank(NE * 9 * 8, f.G, n_idle); __syncthreads();
                if (rk_ >= 0) { const F g = refresh(f); cvt_moe(g, 1, rk_ * NWAVES + g.wave, n_idle * NWAVES, 4); }
                else if ((NE * 9 * 8) % f.G == 0) { const F g = refresh(f); cvt_moe(g, 1, g.gw, g.NGW, 4); } }
        }
        SEAM(pb + 13);
        if (PHE(15) && IN(pb + 14)) for (int rep_ = 0; rep_ < REPS(15); ++rep_) { if (rep_) xcd_barrier(bar); phase_resid2(f, l, keep); }
        SEAM(pb + 14);
    }
#undef IN
#undef SEAM
}

extern "C" void kernel_launch(void* const* d_in, const int* in_sizes, int n_in, void* d_out, int out_size, void* d_ws, size_t ws_size, hipStream_t stream) {
    static int grid = 0;
    if (grid == 0) {
        if (n_in != 32 || out_size != NBATCH * SEQ * D || ws_size < WS_END) { fprintf(stderr, "kernel_launch: unexpected problem: n_in %d out %d ws %zu (need %zu)\n", n_in, out_size, ws_size, (size_t)WS_END); grid = -1; return; }
        int dev = 0, cus = 0, per_cu = 0;
        if (hipGetDevice(&dev) != hipSuccess || hipDeviceGetAttribute(&cus, hipDeviceAttributeMultiprocessorCount, dev) != hipSuccess) { grid = -1; return; }
        if (hipFuncSetAttribute((const void*)mega, hipFuncAttributeMaxDynamicSharedMemorySize, LDS_BYTES) != hipSuccess) { fprintf(stderr, "kernel_launch: hipFuncSetAttribute failed\n"); grid = -1; return; }
        if (hipOccupancyMaxActiveBlocksPerMultiprocessor(&per_cu, (const void*)mega, NTHR, LDS_BYTES) != hipSuccess || per_cu < 1) fprintf(stderr, "kernel_launch: occupancy query says %d\n", per_cu);
        (void)hipGetLastError();
        grid = cus;
    }
    if (grid < 0) return;
    if (hipMemsetAsync((char*)d_ws + WS_CTL, 0, CTL_BYTES, stream) != hipSuccess) return;
    Args a{};
    for (int i = 0; i < 32; ++i) a.in[i] = (const float*)d_in[i];
    a.out = (float*)d_out; a.ws = (unsigned char*)d_ws;
#if N_LAUNCH_MODE == 1
    a.ph_lo = 0; a.ph_hi = NPHASES;
    hipLaunchKernelGGL(mega, dim3(grid), dim3(NTHR), LDS_BYTES, stream, a);
#else
    for (int p = 0; p < NPHASES; ++p) { a.ph_lo = p; a.ph_hi = p + 1; hipLaunchKernelGGL(mega, dim3(grid), dim3(NTHR), LDS_BYTES, stream, a); }
#endif
    const hipError_t le = hipPeekAtLastError();
    if (le != hipSuccess) fprintf(stderr, "kernel_launch: launch failed: %s\n", hipGetErrorName(le));
}
```

```cpp
#include <hip/hip_runtime.h>
#include <stdint.h>
#include <stdio.h>

#ifndef N_LAUNCH_MODE
#define N_LAUNCH_MODE 1
#endif
#ifndef NAIVE_GEMM
#define NAIVE_GEMM 0
#endif
#ifndef NAIVE_ATTN
#define NAIVE_ATTN 0
#endif

#define LAS __attribute__((address_space(3)))
#define GAS __attribute__((address_space(1)))
typedef unsigned short bf16_t;
typedef short bf16x8 __attribute__((ext_vector_type(8)));
typedef short s16x4 __attribute__((ext_vector_type(4)));
typedef float f32x4 __attribute__((ext_vector_type(4)));
typedef float f32x2 __attribute__((ext_vector_type(2)));
typedef float f32x16 __attribute__((ext_vector_type(16)));
typedef unsigned u32x4 __attribute__((ext_vector_type(4)));
typedef unsigned u32x2 __attribute__((ext_vector_type(2)));

constexpr int D = 2048, NBATCH = 4, SEQ = 4096, CTXL = 256, TS = SEQ + CTXL, R = NBATCH * TS;
constexpr int DEPTH = 2, GRIDW = 64;
constexpr int NQH = 8, NKVH = 2, HDIM = 128;
constexpr int COL_K = 1024, COL_V = 1280, COL_POOL = 1536, COL_R = 2560, COL_GATE = 6208, N_IN = 12352, NSHIFT = 3648;
constexpr int PA_W = 6400, PG_W = 6144, NP_TILES = 49;
constexpr int RWH = 16, RHD = 64, LA_W = 576;
constexpr int NE = 16, FF = 1024, CAP_L = 512, CAP_C = 32, ESLOTS = 2304, NSLOT = NE * ESLOTS;
constexpr float NORM_EPS = 1e-6f, GN_EPS = 64e-5f;
constexpr int NWAVES = 8, NTHR = 512;

constexpr size_t al256(size_t x) { return (x + 255) & ~(size_t)255; }
constexpr size_t WS_CTL = 0, CTL_BYTES = 1u << 20;
constexpr size_t WS_MOD = WS_CTL + CTL_BYTES;
constexpr size_t WS_WB = al256(WS_MOD + (size_t)2 * 5 * 12288 * 4);
constexpr size_t WB_WIN = 0;
constexpr size_t WB_WA = WB_WIN + (size_t)12544 * 2048 * 2;
constexpr size_t WB_WP = WB_WA + (size_t)2048 * 1024 * 2;
constexpr size_t WB_WR = WB_WP + (size_t)2048 * 1024 * 2;
constexpr size_t WB_WOUT = WB_WR + (size_t)2048 * 1024 * 2;
constexpr size_t WB_WPG = WB_WOUT + (size_t)2048 * 2048 * 2;
constexpr size_t WB_W2 = WB_WPG + (size_t)4 * 256 * 256 * 2;
constexpr size_t WB_A2 = WB_W2 + (size_t)2 * 1024 * 64 * 2;
constexpr size_t WB_G2 = WB_A2 + (size_t)2 * 1024 * 64 * 2;
constexpr size_t WB_BYTES = al256(WB_G2 + (size_t)1024 * 320 * 2);
constexpr size_t WS_XS = al256(WS_WB + 2 * WB_BYTES);
constexpr size_t WS_H = WS_XS + (size_t)R * D * 2;
constexpr size_t WS_G = WS_H, WS_PL = WS_H + (size_t)R * 1024 * 2;
constexpr size_t WS_AFF = WS_H + (size_t)R * D * 2;
constexpr size_t WS_TOKSLOT = WS_AFF + (size_t)R * 16 * 4;
constexpr size_t WS_SLOTROW = WS_TOKSLOT + (size_t)R * 16 * 4;
constexpr size_t WS_BON = al256(WS_SLOTROW + (size_t)NSLOT * 4);
constexpr size_t WS_T = al256(WS_BON + (size_t)2 * R * 16 * 4);
constexpr size_t T_PA = 0;
constexpr size_t T_AT = T_PA, T_PO = T_AT + (size_t)R * 1024 * 2, T_RW = T_PO + (size_t)R * 1024 * 2, T_MG = T_RW + (size_t)R * 1024 * 2;
constexpr size_t T_PG = T_PA + (size_t)R * PA_W * 2;
constexpr size_t T_MX = T_PG;
constexpr size_t T_QB = T_PG + (size_t)R * PG_W * 2;
constexpr size_t T_KB = T_QB + (size_t)R * 1024 * 2, T_VB = T_KB + (size_t)R * 256 * 2;
constexpr size_t T_WD = T_VB + (size_t)R * 256 * 2;
constexpr size_t T_KD = T_WD + (size_t)2 * R * 1024 * 4;
constexpr size_t T_BD = T_KD + (size_t)2 * R * 1024 * 2;
constexpr size_t T_KK = T_BD + (size_t)2 * R * 1024 * 2;
constexpr size_t T_RR = T_KK + (size_t)R * 1024 * 2, T_VV = T_RR + (size_t)R * 1024 * 2, T_KS = T_VV + (size_t)R * 1024 * 2;
constexpr size_t T_LA = T_KS + (size_t)R * 1024 * 2;
constexpr size_t T_END_MIX = al256(T_LA + (size_t)R * LA_W * 2);
constexpr size_t T_XG = 0, T_HID = T_XG + (size_t)NSLOT * D * 2, T_Y = T_HID + (size_t)NSLOT * FF * 2;
static_assert(T_HID + (size_t)NSLOT * FF * 2 + (size_t)NSLOT * D * 2 <= T_PG + (size_t)R * PG_W * 2, "XG | HID | Y end before the expert weight copies");
constexpr size_t T_WGU = T_QB;
constexpr size_t T_WDN = T_WGU + (size_t)NE * 2048 * 2048 * 2;
constexpr size_t T_END_MOE = T_WDN + (size_t)NE * 2048 * 1024 * 2;
static_assert(T_WDN == T_WGU + (size_t)NE * 2048 * 2048 * 2, "down copy follows the gate/up copy");
constexpr size_t WS_MOE1 = WS_T + (T_END_MIX > T_END_MOE ? T_END_MIX : T_END_MOE);
constexpr size_t MOE_WGU_BYTES = (size_t)NE * 2048 * 2048 * 2, MOE_W_BYTES = MOE_WGU_BYTES + (size_t)NE * 2048 * 1024 * 2;
constexpr size_t WS_END = WS_MOE1 + MOE_W_BYTES;
static_assert(T_MG + (size_t)R * D * 2 <= T_PG, "AT|PO|RW|MG fit in PA");
constexpr int CW_TMO = 0, CW_BAR = 4096;

__device__ __forceinline__ float bf2f(unsigned b) { return __uint_as_float(b << 16); }
__device__ __forceinline__ float bflo(unsigned w) { return __uint_as_float(w << 16); }
__device__ __forceinline__ float bfhi(unsigned w) { return __uint_as_float(w & 0xffff0000u); }
typedef __bf16 bf16x2_t __attribute__((ext_vector_type(2)));
__device__ __forceinline__ unsigned pk2(float lo, float hi) { const bf16x2_t v = __builtin_convertvector((f32x2){lo, hi}, bf16x2_t); return __builtin_bit_cast(unsigned, v); }
__device__ __forceinline__ bf16_t f2bf(float f) { return (bf16_t)(pk2(f, 0.f) & 0xffffu); }
__device__ __forceinline__ float wave_sum(float v) {
#pragma unroll
    for (int o = 1; o < 64; o <<= 1) v += __shfl_xor(v, o);
    return v;
}
__device__ __forceinline__ float sigmoidf_(float x) { return __builtin_amdgcn_rcpf(1.0f + __expf(-x)); }
__device__ __forceinline__ float tanhf_(float x) { return 1.0f - 2.0f * __builtin_amdgcn_rcpf(1.0f + __expf(2.0f * x)); }
namespace rk {
__device__ __forceinline__ u32x2 pk4(const f32x4 v) { u32x2 w; w.x = pk2(v[0], v[1]); w.y = pk2(v[2], v[3]); return w; }
__device__ __forceinline__ f32x4 up4(const u32x2 w) { return (f32x4){bflo(w.x), bfhi(w.x), bflo(w.y), bfhi(w.y)}; }
}
#define LDS_WAIT() asm volatile("s_waitcnt lgkmcnt(0)" ::: "memory")
#define VM_WAIT() asm volatile("s_waitcnt vmcnt(0)" ::: "memory")

#define XB_TMO      128
#define XB_XCNT(j)  (256  + 64 * (j))
#define XB_XSUB(j)  (1280 + 64 * (j))
#define XB_XGEN(j)  (2304 + 64 * (j))
#define XB_TOP      3328
#define XB_TOPGEN   3392
#define XCD_BAR_WORDS 3456
#define XB_SPIN_CAP (1u << 22)
__device__ __forceinline__ unsigned xb_ld(unsigned* p)              { return __hip_atomic_load(p, __ATOMIC_RELAXED, __HIP_MEMORY_SCOPE_AGENT); }
__device__ __forceinline__ unsigned xb_add(unsigned* p, unsigned v) { return __hip_atomic_fetch_add(p, v, __ATOMIC_RELAXED, __HIP_MEMORY_SCOPE_AGENT); }
__device__ __forceinline__ unsigned xb_xcc_id() { return (unsigned)__builtin_amdgcn_s_getreg((3 << 11) | 20) & 0xFu; }
#define XB_SPIN(cond, bar) do { unsigned _sp = 0; while (cond) { __builtin_amdgcn_s_sleep(1); \
    if ((++_sp & 255u) == 0u) { if (xb_ld(&(bar)[XB_TMO])) break; if (_sp > XB_SPIN_CAP) { atomicAdd(&(bar)[XB_TMO], 1u); break; } } } } while (0)
struct XcdBarrier { unsigned* bar; unsigned x; volatile LAS unsigned* st; };
__device__ __forceinline__ XcdBarrier xcd_barrier_post(unsigned* bar, volatile LAS unsigned* st) {
    XcdBarrier b; b.bar = bar; b.x = xb_xcc_id(); b.st = st;
    if (threadIdx.x == 0) (void)xb_add(&bar[XB_XCNT(b.x)], 1u);
    return b;
}
__device__ __forceinline__ void xcd_barrier_complete(unsigned* bar, unsigned x, unsigned& nloc, unsigned& nx) {
    const unsigned G = gridDim.x * gridDim.y * gridDim.z;
    unsigned sum, cnt, mine, sp = 0u;
    for (;;) {
        sum = 0u; cnt = 0u; mine = 0u;
#pragma unroll
        for (unsigned j = 0; j < 16; ++j) { const unsigned c = xb_ld(&bar[XB_XCNT(j)]); sum += c; cnt += (c > 0u) ? 1u : 0u; mine = (j == x) ? c : mine; }
        if (sum == G) break;
        __builtin_amdgcn_s_sleep(1);
        if ((++sp & 255u) == 0u) { if (xb_ld(&bar[XB_TMO])) break; if (sp > XB_SPIN_CAP) { atomicAdd(&bar[XB_TMO], 1u); break; } }
    }
    nloc = mine > 0u ? mine : 1u; nx = cnt > 0u ? cnt : 1u;
}
__device__ __forceinline__ void xcd_barrier(const XcdBarrier& b) {
    asm volatile("s_waitcnt vmcnt(0)" ::: "memory");
    __syncthreads();
    if (threadIdx.x == 0) {
        unsigned* bar = b.bar;
        __builtin_amdgcn_s_waitcnt(0);
        unsigned nloc = b.st[0], nx = b.st[1];
        if (nloc == 0u) { xcd_barrier_complete(bar, b.x, nloc, nx); b.st[0] = nloc; b.st[1] = nx; }
        const unsigned old = xb_add(&bar[XB_XSUB(b.x)], 1u);
        const unsigned gen = old / nloc;
        if (old + 1u == (gen + 1u) * nloc) {
            __builtin_amdgcn_fence(__ATOMIC_RELEASE, "agent");
            asm volatile("s_waitcnt vmcnt(0)" ::: "memory");
            const unsigned og = xb_add(&bar[XB_TOP], 1u);
            const unsigned tg = og / nx;
            if (og + 1u == (tg + 1u) * nx) xb_add(&bar[XB_TOPGEN], 1u);
            else XB_SPIN(xb_ld(&bar[XB_TOPGEN]) == tg, bar);
            __builtin_amdgcn_fence(__ATOMIC_ACQUIRE, "agent");
            xb_add(&bar[XB_XGEN(b.x)], 1u);
            asm volatile("s_waitcnt vmcnt(0)" ::: "memory");
        } else {
            XB_SPIN(xb_ld(&bar[XB_XGEN(b.x)]) == gen, bar);
            __builtin_amdgcn_fence(__ATOMIC_ACQUIRE, "agent");
            asm volatile("s_waitcnt vmcnt(0)" ::: "memory");
        }
    }
    __syncthreads();
}

namespace pg8 {
constexpr int BM = 256, BK = 64, HALF = 128, HTB = HALF * BK * 2, STAGE_BYTES = 8 * HTB;
__host__ __device__ __forceinline__ int lds_byte(int r, int c) { const int st = (r >> 4) * 2 + (c >> 5), rr = r & 15, cc = c & 31, ob = rr * 64 + cc * 2; return st * 1024 + (ob ^ (((ob >> 9) & 1) << 5)); }
__host__ __device__ __forceinline__ void stage_rc(int b, int& Rr, int& C) { const int st = b / 1024, sb = b % 1024, swz = sb ^ (((sb >> 9) & 1) << 5); Rr = (st >> 1) * 16 + swz / 64; C = (st & 1) * 32 + (swz % 64) / 2; }
__host__ __device__ __forceinline__ int perm32(int rho) { const int n = rho >> 4, i = rho & 15; return 8 * (i >> 2) + 4 * n + (i & 3); }
struct Unit { const char* A; const char* B; int pm, pn, aux; const int* gidx; };
struct Desc { int K, lda, ldb; };
typedef f32x4 Acc[2][2][4][2];

#if !NAIVE_GEMM
template <class Epi, class Sched>
__device__ __forceinline__ void gemm_phase(LAS unsigned char* lds, const Desc g, const Sched& S, const Epi& E, const int tid) {
    const int wid = __builtin_amdgcn_readfirstlane(tid >> 6), lane = tid & 63, wr = wid >> 2, wc = wid & 3, fr = lane & 15, fq = lane >> 4;
    int K = g.K; asm volatile("" : "+s"(K)); const int nt = K / BK;
    unsigned voffA[2], voffB[2]; int rrA[2], ccA[2];
#pragma unroll
    for (int i = 0; i < 2; ++i) { int Rr, C; stage_rc(tid * 16 + i * 8192, Rr, C); const int Rb = (Rr & ~31) + perm32(Rr & 31); rrA[i] = Rr; ccA[i] = C;
        voffA[i] = (unsigned)(Rr * g.lda + C) * 2u; voffB[i] = (unsigned)(Rb * g.ldb + C) * 2u; }
    constexpr bool GATHER = Sched::GATHER;
    unsigned cO[2][2], nO[2][2];
#define PG8_GOFF(unit, o) do { _Pragma("unroll") for (int _h = 0; _h < 2; ++_h) _Pragma("unroll") for (int _i = 0; _i < 2; ++_i) { unsigned gi_ = (unsigned)(unit).gidx[_h * HALF + rrA[_i]]; gi_ = gi_ < (unsigned)R ? gi_ : (unsigned)(R - 1); \
        (o)[_h][_i] = (gi_ * (unsigned)g.lda + (unsigned)ccA[_i]) * 2u; } } while (0)
#define PG8_ASTAGE(bufoff, gbase, h, usenext) do { if constexpr (GATHER) { unsigned o_[2] = {(usenext) ? nO[h][0] : cO[h][0], (usenext) ? nO[h][1] : cO[h][1]}; PG8_STAGE(bufoff, gbase, o_); } \
        else { PG8_STAGE(bufoff, (gbase) + ((h) ? hstepA : (size_t)0), voffA); } } while (0)
    const size_t kstep = (size_t)(BK * 2);
    const size_t hstepA = (size_t)HALF * g.lda * 2, hstepB = (size_t)HALF * g.ldb * 2;
    const unsigned ldsw = (unsigned)wid * 1024u;
    const int aoff = lds_byte(wr * 64 + fr, fq * 8), boff = lds_byte(wc * 32 + fr, fq * 8);
#define PG8_SA(b, h) (((b) * 2 + (h)) * HTB)
#define PG8_SB(b, h) ((4 + (b) * 2 + (h)) * HTB)
#define PG8_STAGE(bufoff, gbase, voff) do { _Pragma("unroll") for (int _i = 0; _i < 2; ++_i) \
        __builtin_amdgcn_global_load_lds((const unsigned*)((const char*)(gbase) + (voff)[_i]), (LAS unsigned*)(lds + (bufoff) + ldsw + _i * 8192), 16, 0, 0); } while (0)
#define PG8_LDA(dst, b, h) do { _Pragma("unroll") for (int m = 0; m < 4; ++m) _Pragma("unroll") for (int k = 0; k < 2; ++k) dst[m][k] = *(const LAS bf16x8*)(lds + PG8_SA(b, h) + aoff + m * 2048 + k * 1024); } while (0)
#define PG8_LDB(dst, b, h) do { _Pragma("unroll") for (int n = 0; n < 2; ++n) _Pragma("unroll") for (int k = 0; k < 2; ++k) dst[n][k] = *(const LAS bf16x8*)(lds + PG8_SB(b, h) + boff + n * 2048 + k * 1024); } while (0)
#define PG8_MMA(ai, bj, At, Bt) do { __builtin_amdgcn_s_setprio(1); _Pragma("unroll") for (int m = 0; m < 4; ++m) _Pragma("unroll") for (int n = 0; n < 2; ++n) _Pragma("unroll") for (int k = 0; k < 2; ++k) \
        acc[ai][bj][m][n] = __builtin_amdgcn_mfma_f32_16x16x32_bf16(Bt[n][k], At[m][k], acc[ai][bj][m][n], 0, 0, 0); __builtin_amdgcn_s_setprio(0); } while (0)
#define PG8_WAIT_V(n) asm volatile("s_waitcnt vmcnt(" #n ")" ::: "memory")
#define PG8_WAIT_L(n) asm volatile("s_waitcnt lgkmcnt(" #n ")" ::: "memory")
#define PG8_BAR __builtin_amdgcn_s_barrier()
#define PG8_SCHED __builtin_amdgcn_sched_barrier(0)
    Unit cur, nxt; int ui = 0;
    if (!S.next(0, cur)) return;
    Acc acc;
#pragma unroll
    for (int a = 0; a < 2; ++a)
#pragma unroll
        for (int b = 0; b < 2; ++b)
#pragma unroll
            for (int m = 0; m < 4; ++m)
#pragma unroll
                for (int n = 0; n < 2; ++n) acc[a][b][m][n] = (f32x4){0.f, 0.f, 0.f, 0.f};
    bf16x8 At[4][2], B0[2][2], B1[2][2];
    const char* cA = cur.A; const char* cB = cur.B;
    if constexpr (GATHER) { PG8_GOFF(cur, cO); }
    PG8_STAGE(PG8_SB(0, 0), cB, voffB); PG8_ASTAGE(PG8_SA(0, 0), cA, 0, false); PG8_STAGE(PG8_SB(0, 1), cB + hstepB, voffB); PG8_ASTAGE(PG8_SA(0, 1), cA, 1, false);
    if (wr == 1) PG8_BAR;
    PG8_WAIT_V(4); PG8_BAR;
    PG8_STAGE(PG8_SB(1, 0), cB + kstep, voffB); PG8_ASTAGE(PG8_SA(1, 0), cA + kstep, 0, false); PG8_STAGE(PG8_SB(1, 1), cB + hstepB + kstep, voffB);
    PG8_WAIT_V(6); PG8_BAR;
    for (;;) {
        const bool has_next = S.next(ui + 1, nxt);
        const char* nA = has_next ? nxt.A : cA; const char* nB = has_next ? nxt.B : cB;
        if constexpr (GATHER) { if (has_next) { PG8_GOFF(nxt, nO); } else {
#pragma unroll
            for (int _h = 0; _h < 2; ++_h) { nO[_h][0] = cO[_h][0]; nO[_h][1] = cO[_h][1]; } } }
        for (int t = 0; t < nt; t += 2) {
            const bool last = (t == nt - 2);
            const char* a1 = cA + (size_t)(t + 1) * kstep;
            const char* a2 = last ? nA : cA + (size_t)(t + 2) * kstep; const char* b2 = last ? nB : cB + (size_t)(t + 2) * kstep;
            const char* a3 = a2 + kstep; const char* b3 = b2 + kstep;
            PG8_LDB(B0, 0, 0); PG8_SCHED; PG8_LDA(At, 0, 0); PG8_ASTAGE(PG8_SA(1, 1), a1, 1, false);
            PG8_WAIT_L(8); PG8_BAR; PG8_WAIT_L(0); PG8_MMA(0, 0, At, B0); PG8_BAR; PG8_SCHED;
            PG8_LDB(B1, 0, 1); PG8_STAGE(PG8_SB(0, 0), b2, voffB);
            PG8_BAR; PG8_WAIT_L(0); PG8_MMA(0, 1, At, B1); PG8_BAR;
            PG8_LDA(At, 0, 1); PG8_ASTAGE(PG8_SA(0, 0), a2, 0, last);
            PG8_BAR; PG8_WAIT_L(0); PG8_MMA(1, 0, At, B0); PG8_BAR; PG8_SCHED;
            PG8_STAGE(PG8_SB(0, 1), b2 + hstepB, voffB);
            PG8_WAIT_V(6); PG8_BAR; PG8_MMA(1, 1, At, B1); PG8_BAR;
            PG8_LDB(B0, 1, 0); PG8_SCHED; PG8_LDA(At, 1, 0); PG8_ASTAGE(PG8_SA(0, 1), a2, 1, last);
            PG8_WAIT_L(8); PG8_BAR; PG8_WAIT_L(0); PG8_MMA(0, 0, At, B0); PG8_BAR; PG8_SCHED;
            PG8_LDB(B1, 1, 1); PG8_STAGE(PG8_SB(1, 0), b3, voffB);
            PG8_BAR; PG8_WAIT_L(0); PG8_MMA(0, 1, At, B1); PG8_BAR;
            PG8_LDA(At, 1, 1); PG8_ASTAGE(PG8_SA(1, 0), a3, 0, last);
            PG8_BAR; PG8_WAIT_L(0); PG8_MMA(1, 0, At, B0); PG8_BAR; PG8_SCHED;
            PG8_STAGE(PG8_SB(1, 1), b3 + hstepB, voffB);
            PG8_WAIT_V(6); PG8_BAR; PG8_MMA(1, 1, At, B1); PG8_BAR;
        }
        const bool keep = E(acc, cur, wr, wc, fr, fq);
        if (!has_next) break;
        if (!keep) {
#pragma unroll
            for (int a = 0; a < 2; ++a)
#pragma unroll
                for (int b = 0; b < 2; ++b)
#pragma unroll
                    for (int m = 0; m < 4; ++m)
#pragma unroll
                        for (int n = 0; n < 2; ++n) acc[a][b][m][n] = (f32x4){0.f, 0.f, 0.f, 0.f};
        }
        cur = nxt; cA = nA; cB = nB; ++ui;
        if constexpr (GATHER) {
#pragma unroll
            for (int _h = 0; _h < 2; ++_h) { cO[_h][0] = nO[_h][0]; cO[_h][1] = nO[_h][1]; } }
    }
    PG8_WAIT_V(0);
    if (wr == 0) PG8_BAR;
    PG8_BAR;
#undef PG8_GOFF
#undef PG8_ASTAGE
#undef PG8_SA
#undef PG8_SB
#undef PG8_STAGE
#undef PG8_LDA
#undef PG8_LDB
#undef PG8_MMA
#undef PG8_WAIT_V
#undef PG8_WAIT_L
#undef PG8_BAR
#undef PG8_SCHED
}
#else
template <class Epi, class Sched>
__device__ __forceinline__ void gemm_phase(LAS unsigned char* lds, const Desc g, const Sched& S, const Epi& E, const int tid) {
    const int wid = tid >> 6, lane = tid & 63, wr = wid >> 2, wc = wid & 3, fr = lane & 15, fq = lane >> 4;
    Unit u; Acc acc;
#pragma unroll
    for (int a = 0; a < 2; ++a)
#pragma unroll
        for (int b = 0; b < 2; ++b)
#pragma unroll
            for (int m = 0; m < 4; ++m)
#pragma unroll
                for (int n = 0; n < 2; ++n) acc[a][b][m][n] = (f32x4){0.f, 0.f, 0.f, 0.f};
    for (int i = 0; S.next(i, u); ++i) {
        const bf16_t* A = (const bf16_t*)u.A; const bf16_t* B = (const bf16_t*)u.B;
        for (int k8 = 0; k8 < g.K / 8; ++k8) {
            float af[2][4][8];
#pragma unroll
            for (int ai = 0; ai < 2; ++ai)
#pragma unroll
                for (int m = 0; m < 4; ++m) { const u32x4 w = *(const u32x4*)(A + (size_t)(128 * ai + 64 * wr + 16 * m + fr) * g.lda + k8 * 8);
                    af[ai][m][0] = bflo(w.x); af[ai][m][1] = bfhi(w.x); af[ai][m][2] = bflo(w.y); af[ai][m][3] = bfhi(w.y); af[ai][m][4] = bflo(w.z); af[ai][m][5] = bfhi(w.z); af[ai][m][6] = bflo(w.w); af[ai][m][7] = bfhi(w.w); }
#pragma unroll
            for (int bj = 0; bj < 2; ++bj)
#pragma unroll
                for (int n = 0; n < 2; ++n)
#pragma unroll
                    for (int j = 0; j < 4; ++j) { const u32x4 w = *(const u32x4*)(B + (size_t)(128 * bj + 32 * wc + 8 * fq + 4 * n + j) * g.ldb + k8 * 8);
                        float bf[8]; bf[0] = bflo(w.x); bf[1] = bfhi(w.x); bf[2] = bflo(w.y); bf[3] = bfhi(w.y); bf[4] = bflo(w.z); bf[5] = bfhi(w.z); bf[6] = bflo(w.w); bf[7] = bfhi(w.w);
#pragma unroll
                        for (int ai = 0; ai < 2; ++ai)
#pragma unroll
                            for (int m = 0; m < 4; ++m) { float s = acc[ai][bj][m][n][j];
#pragma unroll
                                for (int q = 0; q < 8; ++q) s += af[ai][m][q] * bf[q];
                                acc[ai][bj][m][n][j] = s; } }
        }
        const bool keep = E(acc, u, wr, wc, fr, fq);
        if (!keep) {
#pragma unroll
            for (int a = 0; a < 2; ++a)
#pragma unroll
                for (int b = 0; b < 2; ++b)
#pragma unroll
                    for (int m = 0; m < 4; ++m)
#pragma unroll
                        for (int n = 0; n < 2; ++n) acc[a][b][m][n] = (f32x4){0.f, 0.f, 0.f, 0.f};
        }
    }
}
#endif

__device__ __forceinline__ void tile_of(int L, int nM, int nN, int& pm, int& pn) {
    const int nwg = nM * nN; int wgid = L; { const int q = nwg / 8, r = nwg % 8, xcd = wgid % 8, off = wgid / 8; wgid = (xcd < r ? xcd * (q + 1) : r * (q + 1) + (xcd - r) * q) + off; }
    const int nig = 8 * nN, gid = wgid / nig, fm = gid * 8, gsz = (nM - fm) < 8 ? (nM - fm) : 8;
    pm = fm + ((wgid % nig) % gsz); pn = (wgid % nig) / gsz;
}
__device__ __forceinline__ void st8(bf16_t* p, const f32x4 v0, const f32x4 v1) { u32x4 w; w.x = pk2(v0[0], v0[1]); w.y = pk2(v0[2], v0[3]); w.z = pk2(v1[0], v1[1]); w.w = pk2(v1[2], v1[3]); *(u32x4*)p = w; }
}

namespace att {
constexpr int DH = 128, NW = 8, QBLK = 32, KVBLK = 64, LDQ = 1024, LDK = 256, LDO = 1024;
constexpr float SCALE = 0.088388347648318440f;
constexpr float THR = 8.f;
constexpr size_t SHM_V = KVBLK * DH * 2, SHM_K = KVBLK * DH * 2, SHM_ATTN = 2 * SHM_V + 2 * SHM_K + NW * 64 * 4;
#if !NAIVE_ATTN
#define KSWZ(row, colB) ((row) * 256 + ((colB) ^ (((row) & 7) << 4)))
#define SBAR() __builtin_amdgcn_sched_barrier(0)
__device__ __forceinline__ int crow(int r, int hi) { return (r & 3) + 8 * (r >> 2) + 4 * hi; }
__device__ __forceinline__ void partialSM(f32x16& p0, f32x16& p1, float& m_reg, float& mn, float& alpha) {
  constexpr float C = SCALE * 1.4426950408889634f;
  float pmax = p0[0]; for (int r = 1; r < 16; ++r) pmax = fmaxf(pmax, p0[r]); for (int r = 0; r < 16; ++r) pmax = fmaxf(pmax, p1[r]);
  { auto rr = __builtin_amdgcn_permlane32_swap(__float_as_uint(pmax), __float_as_uint(pmax), false, false);
    pmax = fmaxf(__uint_as_float(rr[0]), __uint_as_float(rr[1])); }
  if (__builtin_expect(__all(pmax - m_reg <= THR / SCALE), 1)) { mn = m_reg; alpha = 1.f; }
  else { mn = fmaxf(m_reg, pmax); alpha = __builtin_amdgcn_exp2f((m_reg - mn) * C); m_reg = mn; }
  float mnC = -mn * C;
  for (int r = 0; r < 16; ++r) p0[r] = fmaf(p0[r], C, mnC); for (int r = 0; r < 16; ++r) p1[r] = fmaf(p1[r], C, mnC);
  for (int r = 0; r < 16; ++r) p0[r] = __builtin_amdgcn_exp2f(p0[r]);
}
__device__ __forceinline__ void finishSM(f32x16& p0, f32x16& p1, float alpha, float& l_reg, bf16x8& pa0, bf16x8& pa1, bf16x8& pa2, bf16x8& pa3) {
  for (int r = 0; r < 16; ++r) p1[r] = __builtin_amdgcn_exp2f(p1[r]);
  float ps = 0; for (int r = 0; r < 16; ++r) ps += p0[r]; for (int r = 0; r < 16; ++r) ps += p1[r];
  { auto rr = __builtin_amdgcn_permlane32_swap(__float_as_uint(ps), __float_as_uint(ps), false, false);
    ps = __uint_as_float(rr[0]) + __uint_as_float(rr[1]); }
  l_reg = l_reg * alpha + ps;
#define PK4(P, BASE, OUT) do { unsigned a0 = pk2(P[BASE + 0], P[BASE + 1]), a1 = pk2(P[BASE + 2], P[BASE + 3]);   \
    unsigned b0 = pk2(P[BASE + 4], P[BASE + 5]), b1 = pk2(P[BASE + 6], P[BASE + 7]);                              \
    auto r0 = __builtin_amdgcn_permlane32_swap(a0, b0, false, false); auto r1 = __builtin_amdgcn_permlane32_swap(a1, b1, false, false); \
    u32x4 w = {r0[0], r1[0], r0[1], r1[1]}; OUT = *reinterpret_cast<bf16x8*>(&w); } while (0)
  PK4(p0, 0, pa0); PK4(p0, 8, pa1); PK4(p1, 0, pa2); PK4(p1, 8, pa3);
#undef PK4
}
__device__ __forceinline__ void qkt(f32x16& p0, f32x16& p1, const bf16_t* Ks, const bf16x8* qr, int r32, int hi) {
  p0 = f32x16{}; p1 = f32x16{};
  for (int d0 = 0; d0 < 8; ++d0) { int cb = (d0 * 16 + hi * 8) * 2;
    bf16x8 b0 = *reinterpret_cast<const bf16x8*>((const char*)Ks + KSWZ(r32, cb));
    bf16x8 b1 = *reinterpret_cast<const bf16x8*>((const char*)Ks + KSWZ(32 + r32, cb));
    p0 = __builtin_amdgcn_mfma_f32_32x32x16_bf16(b0, qr[d0], p0, 0, 0, 0);
    p1 = __builtin_amdgcn_mfma_f32_32x32x16_bf16(b1, qr[d0], p1, 0, 0, 0); }
}
__device__ __forceinline__ int v_st(int k, int c) { const int kk = (k & ~0xC) | ((k & 4) << 1) | ((k & 8) >> 1); return ((kk >> 3) * 4 + (c >> 5)) * 512 + ((kk & 7) * 32 + (c & 31)) * 2; }
__device__ __forceinline__ int v_rd_base(int lane) { return ((lane & 3) << 3) | (((lane >> 2) & 3) << 6) | (((lane >> 4) & 1) << 5) | (((lane >> 5) & 1) << 8); }
constexpr int v_rd_off(int d0, int ks, int half) { return d0 * 512 + ks * 4096 + half * 2048; }
template <int OFF> __device__ __forceinline__ s16x4 tr_read(int vb) {
  s16x4 r; asm volatile("ds_read_b64_tr_b16 %0, %1 offset:%2" : "=&v"(r) : "v"(vb), "i"(OFF) : "memory"); return r;
}
template <int D0> __device__ __forceinline__ void pv_one(f32x16& od, int vb, bf16x8 pa0, bf16x8 pa1, bf16x8 pa2, bf16x8 pa3) {
  const s16x4 l0 = tr_read<v_rd_off(D0, 0, 0)>(vb), h0 = tr_read<v_rd_off(D0, 0, 1)>(vb), l1 = tr_read<v_rd_off(D0, 1, 0)>(vb), h1 = tr_read<v_rd_off(D0, 1, 1)>(vb);
  const s16x4 l2 = tr_read<v_rd_off(D0, 2, 0)>(vb), h2 = tr_read<v_rd_off(D0, 2, 1)>(vb), l3 = tr_read<v_rd_off(D0, 3, 0)>(vb), h3 = tr_read<v_rd_off(D0, 3, 1)>(vb);
  asm volatile("s_waitcnt lgkmcnt(0)" ::: "memory"); SBAR();
#define PK(L, H) (bf16x8){L[0], L[1], L[2], L[3], H[0], H[1], H[2], H[3]}
  od = __builtin_amdgcn_mfma_f32_32x32x16_bf16(pa0, PK(l0, h0), od, 0, 0, 0);
  od = __builtin_amdgcn_mfma_f32_32x32x16_bf16(pa1, PK(l1, h1), od, 0, 0, 0);
  od = __builtin_amdgcn_mfma_f32_32x32x16_bf16(pa2, PK(l2, h2), od, 0, 0, 0);
  od = __builtin_amdgcn_mfma_f32_32x32x16_bf16(pa3, PK(l3, h3), od, 0, 0, 0);
#undef PK
}
__device__ __forceinline__ void pv_d0(f32x16* o, int vb, bf16x8 pa0, bf16x8 pa1, bf16x8 pa2, bf16x8 pa3) {
  pv_one<0>(o[0], vb, pa0, pa1, pa2, pa3); pv_one<1>(o[1], vb, pa0, pa1, pa2, pa3); pv_one<2>(o[2], vb, pa0, pa1, pa2, pa3); pv_one<3>(o[3], vb, pa0, pa1, pa2, pa3);
}
__device__ __forceinline__ void attn_unit(const bf16_t* __restrict__ Qb, const bf16_t* __restrict__ Kh, const bf16_t* __restrict__ Vh, bf16_t* __restrict__ Ob, int seq, char* lds, const int tid) {
  const int wid = tid >> 6, lane = tid & 63, r32 = lane & 31, hi = lane >> 5;
  bf16_t* V_lds = (bf16_t*)lds; bf16_t* K_lds = (bf16_t*)(lds + 2 * SHM_V);
  float* ws = (float*)(lds + 2 * SHM_V + 2 * SHM_K) + wid * 64; float* li_l = ws; float* al_l = ws + 32;
  float m_reg = -1e30f, l_reg = 0; f32x16 o[4] = {}; bf16x8 qr[8];
  const bf16_t* Qw = Qb + (long)(wid * QBLK + r32) * LDQ + hi * 8;
#pragma unroll
  for (int d0 = 0; d0 < 8; ++d0) qr[d0] = *reinterpret_cast<const bf16x8*>(Qw + d0 * 16);
  const int sr = tid >> 4, sc = (tid & 15) * 8, vst0 = v_st(sr, sc), vst1 = v_st(32 + sr, sc);
  const int vb0 = (int)(uintptr_t)V_lds + v_rd_base(lane);
  struct { bf16x8 vs0, vs1, ks0, ks1; } sr_[2];
  const unsigned voff0 = (unsigned)(sr * LDK + sc) * 2u, voff1 = voff0 + 32u * LDK * 2u;
#define SLOAD(i, k0) do { const char* vb_ = (const char*)Vh + (size_t)(k0) * (LDK * 2); const char* kb_ = (const char*)Kh + (size_t)(k0) * (LDK * 2); \
    sr_[i].vs0 = *(const bf16x8*)(vb_ + voff0); sr_[i].vs1 = *(const bf16x8*)(vb_ + voff1); sr_[i].ks0 = *(const bf16x8*)(kb_ + voff0); sr_[i].ks1 = *(const bf16x8*)(kb_ + voff1); } while (0)
#define SWRITE(b, i) do { *(bf16x8*)((char*)V_lds + (b) * SHM_V + vst0) = sr_[i].vs0;          \
    *(bf16x8*)((char*)V_lds + (b) * SHM_V + vst1) = sr_[i].vs1; int kc = sc * 2;               \
    *(bf16x8*)((char*)K_lds + (b) * SHM_K + KSWZ(sr, kc)) = sr_[i].ks0;                       \
    *(bf16x8*)((char*)K_lds + (b) * SHM_K + KSWZ(32 + sr, kc)) = sr_[i].ks1; } while (0)
#define SWAIT() asm volatile("s_waitcnt vmcnt(4)" ::: "memory")
#define RESC(a) do { if (__any((a) < 1.f)) { if (hi == 0) al_l[r32] = (a); asm volatile("s_waitcnt lgkmcnt(0)" ::: "memory"); \
    for (int d = 0; d < 4; ++d) for (int r = 0; r < 16; ++r) o[d][r] *= al_l[crow(r, hi)]; } } while (0)
  f32x16 pA0, pA1, pB0, pB1; float mnA, mnB, alA, alB; bf16x8 pa0, pa1, pa2, pa3; const int NT = seq / KVBLK;
  constexpr int SE = 0, SO = 1;
  SLOAD(SE, 0); asm volatile("s_waitcnt vmcnt(0)" ::: "memory"); SWRITE(0, SE); __syncthreads();
  qkt(pA0, pA1, K_lds, qr, r32, hi); partialSM(pA0, pA1, m_reg, mnA, alA);
  SLOAD(SO, KVBLK); if (2 < NT) SLOAD(SE, 2 * KVBLK);
  SWAIT(); SWRITE(1, SO); __syncthreads();
  for (int j = 1; j + 1 < NT; j += 2) {
    SBAR(); qkt(pB0, pB1, (bf16_t*)((char*)K_lds + SHM_K), qr, r32, hi);
    finishSM(pA0, pA1, alA, l_reg, pa0, pa1, pa2, pa3); SBAR();
    SLOAD(SO, (j + 2) * KVBLK); SBAR();
    pv_d0(o, vb0, pa0, pa1, pa2, pa3); partialSM(pB0, pB1, m_reg, mnB, alB);
    __syncthreads(); SWAIT(); SWRITE(0, SE);
    RESC(alB); __syncthreads();
    SBAR(); qkt(pA0, pA1, K_lds, qr, r32, hi);
    finishSM(pB0, pB1, alB, l_reg, pa0, pa1, pa2, pa3); SBAR();
    if (j + 3 < NT) SLOAD(SE, (j + 3) * KVBLK); SBAR();
    pv_d0(o, vb0 + (int)SHM_V, pa0, pa1, pa2, pa3); partialSM(pA0, pA1, m_reg, mnA, alA);
    __syncthreads(); SWAIT(); SWRITE(1, SO);
    RESC(alA); __syncthreads();
  }
  SBAR(); qkt(pB0, pB1, (bf16_t*)((char*)K_lds + SHM_K), qr, r32, hi);
  finishSM(pA0, pA1, alA, l_reg, pa0, pa1, pa2, pa3); SBAR();
  pv_d0(o, vb0, pa0, pa1, pa2, pa3); partialSM(pB0, pB1, m_reg, mnB, alB);
  __syncthreads(); RESC(alB);
  finishSM(pB0, pB1, alB, l_reg, pa0, pa1, pa2, pa3); SBAR();
  pv_d0(o, vb0 + (int)SHM_V, pa0, pa1, pa2, pa3);
  if (hi == 0) li_l[r32] = l_reg; asm volatile("s_waitcnt lgkmcnt(0)" ::: "memory");
  float rli[16];
#pragma unroll
  for (int r = 0; r < 16; ++r) rli[r] = __builtin_amdgcn_rcpf(li_l[crow(r, hi)]);
  bf16_t* Ow = Ob + (long)(wid * QBLK) * LDO;
#pragma unroll
  for (int r = 0; r < 16; ++r) { int orow = crow(r, hi);
    for (int d0 = 0; d0 < 4; ++d0) Ow[(long)orow * LDO + d0 * 32 + r32] = f2bf(o[d0][r] * rli[r]); }
  __syncthreads();
#undef SLOAD
#undef SWRITE
#undef SWAIT
#undef RESC
}
#else
__device__ __forceinline__ void attn_unit(const bf16_t* __restrict__ Qb, const bf16_t* __restrict__ Kh, const bf16_t* __restrict__ Vh, bf16_t* __restrict__ Ob, int seq, char* lds, const int tid) {
  const int qi = tid >> 1, hf = tid & 1;
  float q[64], o[64];
#pragma unroll
  for (int i = 0; i < 64; ++i) { q[i] = bf2f(Qb[(long)qi * LDQ + hf * 64 + i]); o[i] = 0.f; }
  float m = -1e30f, l = 0.f;
  for (int kx = 0; kx < seq; ++kx) {
    const u32x4* kp = (const u32x4*)(Kh + (long)kx * LDK + hf * 64); float s = 0.f;
#pragma unroll
    for (int c = 0; c < 8; ++c) { const u32x4 w = kp[c]; s += q[8 * c] * bflo(w.x) + q[8 * c + 1] * bfhi(w.x) + q[8 * c + 2] * bflo(w.y) + q[8 * c + 3] * bfhi(w.y) + q[8 * c + 4] * bflo(w.z) + q[8 * c + 5] * bfhi(w.z) + q[8 * c + 6] * bflo(w.w) + q[8 * c + 7] * bfhi(w.w); }
    s += __shfl_xor(s, 1); s *= SCALE;
    const float mn = fmaxf(m, s), al = __expf(m - mn), p = __expf(s - mn); m = mn; l = l * al + p;
    const u32x4* vp = (const u32x4*)(Vh + (long)kx * LDK + hf * 64);
#pragma unroll
    for (int c = 0; c < 8; ++c) { const u32x4 w = vp[c];
      o[8 * c] = o[8 * c] * al + p * bflo(w.x); o[8 * c + 1] = o[8 * c + 1] * al + p * bfhi(w.x); o[8 * c + 2] = o[8 * c + 2] * al + p * bflo(w.y); o[8 * c + 3] = o[8 * c + 3] * al + p * bfhi(w.y);
      o[8 * c + 4] = o[8 * c + 4] * al + p * bflo(w.z); o[8 * c + 5] = o[8 * c + 5] * al + p * bfhi(w.z); o[8 * c + 6] = o[8 * c + 6] * al + p * bflo(w.w); o[8 * c + 7] = o[8 * c + 7] * al + p * bfhi(w.w); }
  }
  const float rl = 1.f / l;
#pragma unroll
  for (int i = 0; i < 64; ++i) Ob[(long)qi * LDO + hf * 64 + i] = f2bf(o[i] * rl);
}
#endif
}

struct Args { const float* in[32]; float* out; unsigned char* ws; int ph_lo, ph_hi; };
enum { I_X = 0, I_C, I_CTX, I_CCTX, I_WMOD, I_BMOD, I_NPRE, I_NPOST, I_WIN, I_QN, I_KN, I_WAO, I_WPG, I_PSC, I_WPO, I_MU, I_W0, I_W2, I_A0, I_A2, I_G2, I_KK, I_KA, I_RK, I_LNW, I_LNB, I_WRO, I_WOUT,
       I_WRT, I_WEG, I_WEU, I_WED };
typedef __attribute__((address_space(4))) const unsigned char* kargp_t;
struct InTab {
    __device__ __forceinline__ const float* operator[](int i) const {
#if defined(__HIP_DEVICE_COMPILE__)
        kargp_t ka = (kargp_t)__builtin_amdgcn_kernarg_segment_ptr(); asm volatile("" : "+s"(ka)); return (const float*)*(__attribute__((address_space(4))) const uintptr_t*)(ka + 8 * i);
#else
        return nullptr;
#endif
    }
};
struct ArgView { InTab in; float* out; };
struct F {
    LAS unsigned char* lds; const ArgView* a; unsigned char* ws;
    int tid, lane, wave, vcu, G, gw, NGW;
};
__device__ __forceinline__ F refresh(const F& f0) { F f = f0; unsigned zz = 0u; asm volatile("v_mov_b32 %0, 0" : "=v"(zz)); int t = f0.wave * 64 + (int)__builtin_amdgcn_mbcnt_hi(~0u, __builtin_amdgcn_mbcnt_lo(~0u, zz)); f.tid = t; f.lane = t & 63; f.wave = __builtin_amdgcn_readfirstlane(t >> 6); f.gw = f.vcu * NWAVES + f.wave; return f; }
__device__ __forceinline__ int panel_of(int idx, bool keep) { return keep ? idx : (idx >> 4) * 17 + 1 + (idx & 15); }
__device__ __forceinline__ int row_of(int idx, bool keep) { return keep ? idx : (idx >> 12) * TS + CTXL + (idx & 4095); }

template <int MAP> __device__ __forceinline__ int cvt_map(int n0) { return MAP == 0 ? n0 : MAP == 1 ? (n0 < COL_GATE ? n0 : n0 + (PA_W - COL_GATE)) : MAP == 2 ? ((n0 >> 7) * 256 + (n0 & 127)) : ((n0 >> 7) * 256 + 128 + (n0 & 127)); }
template <int MAP> __device__ __forceinline__ void cvt_T(const F& f, const float* src, int nb, int K, int N, bf16_t* dst, int dst_batch_rows, int& off, int vgw = -1, int vngw = 0) {
    LAS float* scr = (LAS float*)(f.lds + f.wave * (64 * 65 * 4));
    int lane = f.lane; asm volatile("" : "+v"(lane));
    const int nblk = N / 64, per = (K / 64) * nblk, items = nb * per;
    const int ks = lane >> 4, n4 = (lane & 15) * 4, nsub = lane >> 3, c = lane & 7;
    int gwl = vngw ? vgw : f.gw, ngwl = vngw ? vngw : f.NGW; asm volatile("" : "+s"(gwl));
    for (int it = gwl; it < items; it += ngwl) {
        const int b = it / per, rem = it % per, kb = rem / nblk, nbk = rem % nblk, k0 = 64 * kb, n0 = 64 * nbk;
        const float* W = src + (size_t)b * K * N + (size_t)k0 * N + n0 + n4;
        f32x4 v[16];
#pragma unroll
        for (int i = 0; i < 16; ++i) v[i] = __builtin_nontemporal_load((const f32x4*)(W + (size_t)(4 * i + ks) * N));
#pragma unroll
        for (int i = 0; i < 16; ++i) { LAS float* d = scr + (4 * i + ks) * 65 + n4; d[0] = v[i].x; d[1] = v[i].y; d[2] = v[i].z; d[3] = v[i].w; }
        LDS_WAIT(); asm volatile("" ::: "memory");
        bf16_t* drow = dst + ((size_t)b * dst_batch_rows + cvt_map<MAP>(n0)) * K + k0 + 8 * c;
#pragma unroll
        for (int j = 0; j < 8; ++j) { const int n = nsub + 8 * j; const LAS float* sp = scr + (8 * c) * 65 + n;
            u32x4 o; o.x = pk2(sp[0 * 65], sp[1 * 65]); o.y = pk2(sp[2 * 65], sp[3 * 65]); o.z = pk2(sp[4 * 65], sp[5 * 65]); o.w = pk2(sp[6 * 65], sp[7 * 65]);
            *(u32x4*)(drow + (size_t)n * K) = o; }
        LDS_WAIT(); asm volatile("" ::: "memory");
    }
    off += items;
}
__device__ __forceinline__ void cvt_wb(const F& f, int l, int vgw, int vngw) {
    const ArgView& a = *f.a; int off = 0; unsigned char* wb = f.ws + WS_WB + (size_t)l * WB_BYTES;
    cvt_T<1>(f, a.in[I_WIN] + (size_t)l * 2048 * N_IN, 1, 2048, N_IN, (bf16_t*)(wb + WB_WIN), 0, off, vgw, vngw);
    cvt_T<0>(f, a.in[I_WAO] + (size_t)l * 1024 * 2048, 1, 1024, 2048, (bf16_t*)(wb + WB_WA), 0, off, vgw, vngw);
    cvt_T<0>(f, a.in[I_WPO] + (size_t)l * 1024 * 2048, 1, 1024, 2048, (bf16_t*)(wb + WB_WP), 0, off, vgw, vngw);
    cvt_T<0>(f, a.in[I_WRO] + (size_t)l * 1024 * 2048, 1, 1024, 2048, (bf16_t*)(wb + WB_WR), 0, off, vgw, vngw);
    cvt_T<0>(f, a.in[I_WOUT] + (size_t)l * 2048 * 2048, 1, 2048, 2048, (bf16_t*)(wb + WB_WOUT), 0, off, vgw, vngw);
    cvt_T<0>(f, a.in[I_WPG] + (size_t)l * 4 * 256 * 256, 4, 256, 256, (bf16_t*)(wb + WB_WPG), 256, off, vgw, vngw);
    cvt_T<0>(f, a.in[I_W2] + (size_t)l * 2 * 64 * 1024, 2, 64, 1024, (bf16_t*)(wb + WB_W2), 1024, off, vgw, vngw);
    cvt_T<0>(f, a.in[I_A2] + (size_t)l * 2 * 64 * 1024, 2, 64, 1024, (bf16_t*)(wb + WB_A2), 1024, off, vgw, vngw);
    cvt_T<0>(f, a.in[I_G2] + (size_t)l * 320 * 1024, 1, 320, 1024, (bf16_t*)(wb + WB_G2), 0, off, vgw, vngw);
}
__device__ __forceinline__ void phase_prologue(const F& f0) {
    const F f = refresh(f0);
    const ArgView& a = *f.a;
    LAS float* S = (LAS float*)f.lds; LAS float* Pp = S + 5 * 2048;
    for (int i = f.tid; i < 5 * 2048; i += NTHR) { const int m = i >> 11, k = i & 2047; const float v = (m < 4) ? a.in[I_C][m * 2048 + k] : a.in[I_CCTX][k]; S[i] = v / (1.0f + __expf(-v)); }
    __syncthreads();
    float* MOD = (float*)(f.ws + WS_MOD);
    for (int u = f.vcu; u < 2 * 96; u += f.G) {
        int ln = f.lane; asm volatile("" : "+v"(ln));
        const int l = u / 96, cb = u % 96, c4 = (ln & 31) * 4, kp = ln >> 5;
        const float* W = a.in[I_WMOD] + (size_t)l * 2048 * 12288 + cb * 128 + c4;
        f32x4 a0 = {0.f, 0.f, 0.f, 0.f}, a1 = a0, a2 = a0, a3 = a0, a4 = a0;
#pragma unroll 8
        for (int k = f.wave * 256 + kp; k < f.wave * 256 + 256; k += 2) { const f32x4 w4 = *(const f32x4*)(W + (size_t)k * 12288); a0 += w4 * S[k]; a1 += w4 * S[2048 + k]; a2 += w4 * S[4096 + k]; a3 += w4 * S[6144 + k]; a4 += w4 * S[8192 + k]; }
        const int ksl = f.wave * 2 + kp;
        *(LAS f32x4*)(Pp + (ksl * 5 + 0) * 128 + c4) = a0; *(LAS f32x4*)(Pp + (ksl * 5 + 1) * 128 + c4) = a1; *(LAS f32x4*)(Pp + (ksl * 5 + 2) * 128 + c4) = a2; *(LAS f32x4*)(Pp + (ksl * 5 + 3) * 128 + c4) = a3; *(LAS f32x4*)(Pp + (ksl * 5 + 4) * 128 + c4) = a4;
        __syncthreads();
        for (int o = f.tid; o < 5 * 128; o += NTHR) { const int m = o >> 7, col = o & 127; float sum = 0.f;
#pragma unroll
            for (int q = 0; q < 16; ++q) sum += Pp[(q * 5 + m) * 128 + col];
            MOD[(size_t)(l * 5 + m) * 12288 + cb * 128 + col] = sum + a.in[I_BMOD][l * 12288 + cb * 128 + col]; }
        __syncthreads();
    }
    __syncthreads();
    cvt_wb(f, 0, f.gw, f.NGW);
}

__device__ __forceinline__ void row_ld_f32(const float* p, f32x4 (&v)[8], int lane) {
#pragma unroll
    for (int j = 0; j < 8; ++j) v[j] = *(const f32x4*)(p + (j * 64 + lane) * 4);
}
__device__ __forceinline__ void row_ld_bf16(const bf16_t* p, f32x4 (&v)[8], int lane) {
#pragma unroll
    for (int j = 0; j < 8; ++j) { const u32x2 w = *(const u32x2*)(p + (j * 64 + lane) * 4); v[j] = (f32x4){bflo(w.x), bfhi(w.x), bflo(w.y), bfhi(w.y)}; }
}
__device__ __forceinline__ float row_rstd(const f32x4 (&v)[8]) {
    float s = 0.f;
#pragma unroll
    for (int j = 0; j < 8; ++j) s += (v[j].x * v[j].x + v[j].y * v[j].y) + (v[j].z * v[j].z + v[j].w * v[j].w);
    return rsqrtf(wave_sum(s) * (1.0f / D) + NORM_EPS);
}
__device__ __forceinline__ void row_modnorm(const f32x4 (&v)[8], float rstd, const float* g, const float* shift, const float* scale, f32x4 (&y)[8], int lane) {
#pragma unroll
    for (int j = 0; j < 8; ++j) { const int e = (j * 64 + lane) * 4; const f32x4 gg = *(const f32x4*)(g + e), sh = *(const f32x4*)(shift + e), sc = *(const f32x4*)(scale + e);
        y[j] = v[j] * rstd * gg * (sc + 1.0f) + sh; }
}
__device__ __forceinline__ void row_st_bf16(bf16_t* p, const f32x4 (&y)[8], int lane) {
#pragma unroll
    for (int j = 0; j < 8; ++j) { u32x2 w; w.x = pk2(y[j].x, y[j].y); w.y = pk2(y[j].z, y[j].w); *(u32x2*)(p + (j * 64 + lane) * 4) = w; }
}
__device__ __forceinline__ const float* mod_vec(const F& f, int l, int row, int chunk) {
    const int b = row / TS, t = row % TS; const int m = (t < CTXL) ? 4 : b;
    return (const float*)(f.ws + WS_MOD) + (size_t)(l * 5 + m) * 12288 + chunk * 2048;
}

__device__ __forceinline__ void phase_norm1(const F& f0, int l) {
    const F f = refresh(f0);
    const ArgView& a = *f.a; const bf16_t* XS = (const bf16_t*)(f.ws + WS_XS); bf16_t* H = (bf16_t*)(f.ws + WS_H);
    LAS float* lv = (LAS float*)f.lds;
    const int c0 = (int)((long)f.vcu * R / f.G), c1 = (int)((long)(f.vcu + 1) * R / f.G);
    for (int s0 = c0; s0 < c1; ) {
        const int tS = s0 % TS; const int nextb = (tS < CTXL) ? s0 - tS + CTXL : s0 - tS + TS; const int s1 = nextb < c1 ? nextb : c1;
        __syncthreads();
        { const float* v0 = a.in[I_NPRE] + (size_t)(l * 2 + 0) * D; const float* v1 = mod_vec(f, l, s0, 0); const float* v2 = mod_vec(f, l, s0, 1);
          for (int i = f.tid; i < 2048 / 4; i += NTHR) { *(LAS f32x4*)(lv + 4 * i) = *(const f32x4*)(v0 + 4 * i); *(LAS f32x4*)(lv + 2048 + 4 * i) = *(const f32x4*)(v1 + 4 * i); *(LAS f32x4*)(lv + 4096 + 4 * i) = *(const f32x4*)(v2 + 4 * i); } }
        LDS_WAIT(); __syncthreads();
        for (int row = s0 + f.wave; row < s1; row += NWAVES) {
            const int b = row / TS, t = row % TS; f32x4 v[8];
            if (l == 0) { const float* src = (t < CTXL) ? a.in[I_CTX] + ((size_t)b * CTXL + t) * D : a.in[I_X] + ((size_t)b * SEQ + (t - CTXL)) * D; row_ld_f32(src, v, f.lane); }
            else row_ld_bf16(XS + (size_t)row * D, v, f.lane);
            const float rstd = row_rstd(v); f32x4 y[8];
#pragma unroll
            for (int j = 0; j < 8; ++j) { const int e = (j * 64 + f.lane) * 4; const f32x4 gg = *(const LAS f32x4*)(lv + e), sh = *(const LAS f32x4*)(lv + 2048 + e), sc = *(const LAS f32x4*)(lv + 4096 + e); y[j] = v[j] * rstd * gg * (sc + 1.0f) + sh; }
            row_st_bf16(H + (size_t)row * D, y, f.lane);
        }
        s0 = s1;
    }
    __syncthreads();
}

struct SchedTiles { static constexpr bool GATHER = false;
    const char* A; const char* B; size_t a_tile, b_tile; int G, c, nM, nN; bool keep;
    __device__ __forceinline__ bool next(int i, pg8::Unit& u) const { const int L = i * G + c; if (L >= nM * nN) return false; int pm, pn; pg8::tile_of(L, nM, nN, pm, pn);
        pm = panel_of(pm, keep); u.A = A + (size_t)pm * a_tile; u.B = B + (size_t)pn * b_tile; u.pm = pm; u.pn = pn; u.aux = pn * 256; return true; }
};
struct SchedP { static constexpr bool GATHER = false;
    const char* A; const char* B; int G, c; bool keep;
    __device__ __forceinline__ bool next(int i, pg8::Unit& u) const { const int L = i * G + c; int pm, pn;
        if (keep) { if (L >= (R / 256) * NP_TILES) return false; pg8::tile_of(L, R / 256, NP_TILES, pm, pn); }
        else { constexpr int NL = NBATCH * 16 * NP_TILES; if (L >= NL + NBATCH * 15) return false;
            if (L < NL) { pg8::tile_of(L, NBATCH * 16, NP_TILES, pm, pn); pm = panel_of(pm, false); } else { const int x = L - NL, t = x % 15; pm = (x / 15) * 17; pn = t < 2 ? 4 + t : 8 + t; } }
        u.A = A + (size_t)pm * 256 * 2048 * 2; u.B = B + (size_t)pn * 256 * 2048 * 2; u.pm = pm; u.pn = pn; u.aux = pn * 256; return true; }
};
struct EpiP { bf16_t* PA; bf16_t* PG;
    __device__ __forceinline__ bool operator()(pg8::Acc& acc, const pg8::Unit& u, int wr, int wc, int fr, int fq) const {
        asm volatile("" : "+v"(fr), "+v"(fq));
        if (u.pn < 25) {
#pragma unroll
            for (int ai = 0; ai < 2; ++ai)
#pragma unroll
                for (int m = 0; m < 4; ++m) { bf16_t* rowp = PA + (size_t)(u.pm * 256 + 128 * ai + 64 * wr + 16 * m + fr) * PA_W + u.pn * 256 + 32 * wc + 8 * fq;
#pragma unroll
                    for (int bj = 0; bj < 2; ++bj) pg8::st8(rowp + 128 * bj, acc[ai][bj][m][0], acc[ai][bj][m][1]); }
        } else {
            bf16_t* tb = PG + (((size_t)u.pm * 24 + (u.pn - 25)) * 8 + (wr * 4 + wc)) * (16 * 64 * 8) + (fq * 16 + fr) * 8;
#pragma unroll
            for (int ai = 0; ai < 2; ++ai)
#pragma unroll
                for (int m = 0; m < 4; ++m)
#pragma unroll
                    for (int bj = 0; bj < 2; ++bj) { f32x4 v0 = acc[ai][bj][m][0], v1 = acc[ai][bj][m][1];
#pragma unroll
                        for (int j = 0; j < 4; ++j) { v0[j] = 1.0f + __expf(-fminf(fmaxf(v0[j], -30.f), 30.f)); v1[j] = 1.0f + __expf(-fminf(fmaxf(v1[j], -30.f), 30.f)); }
                        pg8::st8(tb + (ai * 8 + m * 2 + bj) * (64 * 8), v0, v1); }
        }
        return false; }
};
struct EpiStore { bf16_t* C; int ldc; const float* colscale;
    __device__ __forceinline__ bool operator()(pg8::Acc& acc, const pg8::Unit& u, int wr, int wc, int fr, int fq) const {
        asm volatile("" : "+v"(fr), "+v"(fq));
#pragma unroll
        for (int bj = 0; bj < 2; ++bj) { const int col = u.aux + 128 * bj + 32 * wc + 8 * fq;
            f32x4 s0 = (f32x4){1.f, 1.f, 1.f, 1.f}, s1 = s0; if (colscale) { s0 = *(const f32x4*)(colscale + col); s1 = *(const f32x4*)(colscale + col + 4); }
#pragma unroll
            for (int ai = 0; ai < 2; ++ai)
#pragma unroll
                for (int m = 0; m < 4; ++m) pg8::st8(C + (size_t)(u.pm * 256 + 128 * ai + 64 * wr + 16 * m + fr) * ldc + col, acc[ai][bj][m][0] * s0, acc[ai][bj][m][1] * s1); }
        return false; }
};

__device__ __forceinline__ void ld8bf(const bf16_t* p, float (&x)[8]) { const u32x4 w = *(const u32x4*)p; x[0] = bflo(w.x); x[1] = bfhi(w.x); x[2] = bflo(w.y); x[3] = bfhi(w.y); x[4] = bflo(w.z); x[5] = bfhi(w.z); x[6] = bflo(w.w); x[7] = bfhi(w.w); }
__device__ __forceinline__ void st8bf(bf16_t* p, const float (&x)[8]) { u32x4 w; w.x = pk2(x[0], x[1]); w.y = pk2(x[2], x[3]); w.z = pk2(x[4], x[5]); w.w = pk2(x[6], x[7]); *(u32x4*)p = w; }
template <int WIN> __device__ __forceinline__ void pool_item(const bf16_t* PA, bf16_t* PL, int row, int ch) {
    const int t = row % TS; const bool is_lat = t >= CTXL; const int tt = is_lat ? t - CTXL : t, Tq = is_lat ? SEQ : CTXL;
    const int lo = max(tt - WIN / 2, 0), hi = min(tt + WIN - WIN / 2, Tq);
    const bf16_t* pc = PA + (size_t)(row - tt) * PA_W + COL_POOL + ch * 8; float sum[8], x[8], self[8];
#pragma unroll
    for (int j = 0; j < 8; ++j) sum[j] = 0.f;
#pragma unroll
    for (int d = 0; d < WIN; ++d) { const int p = tt - WIN / 2 + d; const bool ok = (p >= 0) && (p < Tq); const int pcl = min(max(p, 0), Tq - 1); ld8bf(pc + (size_t)pcl * PA_W, x); const float wgt = ok ? 1.f : 0.f;
#pragma unroll
        for (int j = 0; j < 8; ++j) sum[j] += wgt * x[j]; if (d == WIN / 2) {
#pragma unroll
            for (int j = 0; j < 8; ++j) self[j] = x[j]; } }
    const float rc = 1.0f / (float)(hi - lo);
#pragma unroll
    for (int j = 0; j < 8; ++j) sum[j] = sum[j] * rc - self[j];
    st8bf(PL + (size_t)row * 1024 + ch * 8, sum);
}
__device__ __forceinline__ void phase_prep_rows(const F& f0, int l) {
    const F f = refresh(f0);
    const ArgView& a = *f.a; unsigned char* T = f.ws + WS_T;
    const bf16_t* PA = (const bf16_t*)(T + T_PA);
    bf16_t* QB = (bf16_t*)(T + T_QB); bf16_t* KB = (bf16_t*)(T + T_KB); bf16_t* VB = (bf16_t*)(T + T_VB); bf16_t* PL = (bf16_t*)(f.ws + WS_PL);
    bf16_t* KK = (bf16_t*)(T + T_KK); bf16_t* RR = (bf16_t*)(T + T_RR); bf16_t* VV = (bf16_t*)(T + T_VV); bf16_t* KS = (bf16_t*)(T + T_KS); bf16_t* LA = (bf16_t*)(T + T_LA);
    const float* mu = a.in[I_MU] + (size_t)l * NSHIFT; const float* k_k = a.in[I_KK] + (size_t)l * 1024;
    const float* qn = a.in[I_QN] + (size_t)l * 128; const float* kn = a.in[I_KN] + (size_t)l * 128;
    LAS float* cst = (LAS float*)(f.lds + f.wave * 512);
    LAS float* lmu = (LAS float*)(f.lds + NWAVES * 512); LAS float* lkk = lmu + NSHIFT; LAS float* lqk = lkk + 1024;
    for (int i = f.tid; i < NSHIFT; i += NTHR) lmu[i] = mu[i];
    for (int i = f.tid; i < 1024; i += NTHR) lkk[i] = k_k[i];
    if (f.tid < 256) lqk[f.tid] = f.tid < 128 ? qn[f.tid] : kn[f.tid - 128];
    LDS_WAIT(); __syncthreads();
    for (int row = f.gw; row < R; row += f.NGW) {
        int lane = f.lane; asm volatile("" : "+v"(lane));
        const int t = row % TS; const bool is_lat = t >= CTXL; const int tt = is_lat ? t - CTXL : t, Tq = is_lat ? SEQ : CTXL;
        const bool hp = tt > 0, hn = tt < Tq - 1;
        const bf16_t* pu = PA + (size_t)row * PA_W + COL_R;
        u32x4 ru[8], rp[8], rn[8];
#pragma unroll
        for (int it = 0; it < 8; ++it) { const int ch = lane + 64 * it; const int c0 = (ch < NSHIFT / 8 ? ch : 0) * 8; const u32x4 zz = {0u, 0u, 0u, 0u};
            ru[it] = *(const u32x4*)(pu + c0); rp[it] = hp ? *(const u32x4*)(pu - PA_W + c0) : zz; rn[it] = hn ? *(const u32x4*)(pu + PA_W + c0) : zz;
 }
        u32x4 qx1[2], qx2[2]; u32x2 vraw;
        { const bf16_t* pr0 = PA + (size_t)row * PA_W;
#pragma unroll
          for (int pass = 0; pass < 2; ++pass) { const int slot = lane + 64 * pass; const int sl = slot < 80 ? slot : 0; const int hh = sl >> 3, sub = sl & 7, a2 = sub >> 2, fb = sub & 3, base = hh * 128 + a2 * 64 + 8 * fb;
              qx1[pass] = *(const u32x4*)(pr0 + base); qx2[pass] = *(const u32x4*)(pr0 + base + 32);
 }
          vraw = *(const u32x2*)(pr0 + COL_V + lane * 4); }
        asm volatile("" ::: "memory");
#pragma unroll
        for (int it = 0; it < 8; ++it) { const int ch = lane + 64 * it; if (ch < NSHIFT / 8) { const int c0 = ch * 8;
            float u[8], p[8], n[8], s[8];
            u[0] = bflo(ru[it].x); u[1] = bfhi(ru[it].x); u[2] = bflo(ru[it].y); u[3] = bfhi(ru[it].y); u[4] = bflo(ru[it].z); u[5] = bfhi(ru[it].z); u[6] = bflo(ru[it].w); u[7] = bfhi(ru[it].w);
            p[0] = bflo(rp[it].x); p[1] = bfhi(rp[it].x); p[2] = bflo(rp[it].y); p[3] = bfhi(rp[it].y); p[4] = bflo(rp[it].z); p[5] = bfhi(rp[it].z); p[6] = bflo(rp[it].w); p[7] = bfhi(rp[it].w);
            n[0] = bflo(rn[it].x); n[1] = bfhi(rn[it].x); n[2] = bflo(rn[it].y); n[3] = bfhi(rn[it].y); n[4] = bflo(rn[it].z); n[5] = bfhi(rn[it].z); n[6] = bflo(rn[it].w); n[7] = bfhi(rn[it].w);
            const f32x4 m0 = *(const LAS f32x4*)(lmu + c0), m1 = *(const LAS f32x4*)(lmu + c0 + 4);
#pragma unroll
            for (int j = 0; j < 8; ++j) { const float mj = j < 4 ? m0[j] : m1[j - 4]; s[j] = u[j] + (0.5f * (p[j] + n[j]) - u[j]) * mj; }
            if (it < 2) st8bf(RR + (size_t)row * 1024 + c0, s);
            else if (it < 4) { st8bf(KS + (size_t)row * 1024 + (c0 - 1024), s);
                const f32x4 k0 = *(const LAS f32x4*)(lkk + c0 - 1024), k1 = *(const LAS f32x4*)(lkk + c0 - 1024 + 4); float q[8], ss = 0.f;
#pragma unroll
                for (int j = 0; j < 8; ++j) { q[j] = s[j] * (j < 4 ? k0[j] : k1[j - 4]); ss += q[j] * q[j]; }
                ss += __shfl_xor(ss, 1); ss += __shfl_xor(ss, 2); ss += __shfl_xor(ss, 4);
                const float inv = 1.0f / fmaxf(sqrtf(ss), 1e-12f);
#pragma unroll
                for (int j = 0; j < 8; ++j) q[j] *= inv;
                st8bf(KK + (size_t)row * 1024 + (c0 - 1024), q); }
            else if (it < 6) st8bf(VV + (size_t)row * 1024 + (c0 - 2048), s);
            else { float o[8]; int dc;
                if (c0 < 3200) { for (int j = 0; j < 8; ++j) o[j] = tanhf_(s[j]); dc = c0 - 3072; }
                else if (c0 < 3328) { for (int j = 0; j < 8; ++j) o[j] = s[j]; dc = 128 + (c0 - 3200); }
                else { for (int j = 0; j < 8; ++j) o[j] = sigmoidf_(s[j]); dc = 256 + (c0 - 3328); }
                st8bf(LA + (size_t)row * LA_W + dc, o); }
        } }
        { const int ax = lane >> 5, fi = lane & 31; const int pos = is_lat ? (ax == 0 ? tt / GRIDW : tt % GRIDW) : 0;
          const float inv = exp2f(-(float)(2 * fi) * (1.0f / 64.0f) * 13.287712379549449f);
          float sn, cs; sincosf((float)pos * inv, &sn, &cs); cst[lane] = cs; cst[64 + lane] = sn;
          LDS_WAIT(); asm volatile("" ::: "memory");
          const bf16_t* pr = PA + (size_t)row * PA_W;
#pragma unroll
          for (int pass = 0; pass < 2; ++pass) { const int slot = lane + 64 * pass; const bool act = slot < 80; const int sl = act ? slot : 0;
              const int hh = sl >> 3, sub = sl & 7, a2 = sub >> 2, fb = sub & 3, base = hh * 128 + a2 * 64 + 8 * fb;
              float x1[8], x2[8]; { const u32x4 wa = qx1[pass], wb2 = qx2[pass];
                  x1[0] = bflo(wa.x); x1[1] = bfhi(wa.x); x1[2] = bflo(wa.y); x1[3] = bfhi(wa.y); x1[4] = bflo(wa.z); x1[5] = bfhi(wa.z); x1[6] = bflo(wa.w); x1[7] = bfhi(wa.w);
                  x2[0] = bflo(wb2.x); x2[1] = bfhi(wb2.x); x2[2] = bflo(wb2.y); x2[3] = bfhi(wb2.y); x2[4] = bflo(wb2.z); x2[5] = bfhi(wb2.z); x2[6] = bflo(wb2.w); x2[7] = bfhi(wb2.w); }
              float ss = 0.f;
#pragma unroll
              for (int j = 0; j < 8; ++j) ss += x1[j] * x1[j] + x2[j] * x2[j];
              ss += __shfl_xor(ss, 1); ss += __shfl_xor(ss, 2); ss += __shfl_xor(ss, 4);
              const float rstd = rsqrtf(ss * (1.0f / 128.0f) + NORM_EPS);
              const LAS float* nw = lqk + (hh < 8 ? 0 : 128) + a2 * 64 + 8 * fb; const f32x4 w1a = *(const LAS f32x4*)nw, w1b = *(const LAS f32x4*)(nw + 4), w2a = *(const LAS f32x4*)(nw + 32), w2b = *(const LAS f32x4*)(nw + 36);
              const f32x4 c0v = *(const LAS f32x4*)(cst + a2 * 32 + 8 * fb), c1v = *(const LAS f32x4*)(cst + a2 * 32 + 8 * fb + 4), s0v = *(const LAS f32x4*)(cst + 64 + a2 * 32 + 8 * fb), s1v = *(const LAS f32x4*)(cst + 64 + a2 * 32 + 8 * fb + 4);
              float y1[8], y2[8];
#pragma unroll
              for (int j = 0; j < 8; ++j) { const float a1 = x1[j] * rstd * (j < 4 ? w1a[j] : w1b[j - 4]), b1 = x2[j] * rstd * (j < 4 ? w2a[j] : w2b[j - 4]); const float cc = j < 4 ? c0v[j] : c1v[j - 4], sn2 = j < 4 ? s0v[j] : s1v[j - 4];
                  y1[j] = is_lat ? a1 * cc - b1 * sn2 : a1; y2[j] = is_lat ? b1 * cc + a1 * sn2 : b1; }
              if (act) { bf16_t* dst = hh < 8 ? QB + (size_t)row * 1024 + hh * 128 : KB + (size_t)row * 256 + (hh - 8) * 128; st8bf(dst + a2 * 64 + 8 * fb, y1); st8bf(dst + a2 * 64 + 32 + 8 * fb, y2); } }
          *(u32x2*)(VB + (size_t)row * 256 + lane * 4) = vraw;
          asm volatile("" ::: "memory"); }
    }
    { int gt = f.vcu * NTHR + f.tid; asm volatile("" : "+v"(gt));
      for (int idx = gt; idx < R * 128; idx += f.G * NTHR) { const int g = idx / (R * 32), rem = idx % (R * 32), row = rem >> 5, ch = g * 32 + (rem & 31);
          if (g == 0) pool_item<2>(PA, PL, row, ch); else if (g == 1) pool_item<4>(PA, PL, row, ch); else if (g == 2) pool_item<8>(PA, PL, row, ch); else pool_item<16>(PA, PL, row, ch); } }
}
namespace lr { constexpr int P320 = 656; }
__device__ __forceinline__ void phase_prep_lora(const F& f0, int l) {
    const F f = refresh(f0);
    const unsigned char* wb = f.ws + WS_WB + (size_t)l * WB_BYTES; unsigned char* T = f.ws + WS_T; bf16_t* Gg = (bf16_t*)(f.ws + WS_G);
    const int cb = f.vcu & 15, rg = f.vcu >> 4, ngrp = f.G >> 4;
    for (int i = f.tid; i < 64 * 40; i += NTHR) { const int n = i / 40, c = i % 40; *(LAS u32x4*)(f.lds + n * lr::P320 + c * 16) = *(const u32x4*)((const bf16_t*)(wb + WB_G2) + (size_t)(cb * 64 + n) * 320 + c * 8); }
    LDS_WAIT(); __syncthreads();
    for (int t = rg + ngrp * f.wave; t < R / 16; t += ngrp * NWAVES) {
        int lane = f.lane; asm volatile("" : "+v"(lane));
        const int r0 = t * 16, fr = lane & 15, fq = lane >> 4; const size_t row = (size_t)(r0 + fr);
        const bf16_t* LAp = (const bf16_t*)(T + T_LA) + row * LA_W + 256 + 8 * fq;
        bf16x8 afa[10];
#pragma unroll
        for (int i = 0; i < 10; ++i) afa[i] = *(const bf16x8*)(LAp + 32 * i);
#pragma unroll
        for (int nt = 0; nt < 4; ++nt) { f32x4 acc = (f32x4){0.f, 0.f, 0.f, 0.f};
#pragma unroll
            for (int ks = 0; ks < 10; ++ks) acc = __builtin_amdgcn_mfma_f32_16x16x32_bf16(*(const LAS bf16x8*)(f.lds + (16 * nt + fr) * lr::P320 + (32 * ks + 8 * fq) * 2), afa[ks], acc, 0, 0, 0);
            *(u32x2*)(Gg + row * 1024 + cb * 64 + 16 * nt + 4 * fq) = rk::pk4(acc); }
    }
}

__device__ __forceinline__ void phase_attn(const F& f0, bool keep) {
    const F f = refresh(f0);
    unsigned char* T = f.ws + WS_T; const bf16_t* QB = (const bf16_t*)(T + T_QB); const bf16_t* KB = (const bf16_t*)(T + T_KB); const bf16_t* VB = (const bf16_t*)(T + T_VB); bf16_t* AT = (bf16_t*)(T + T_AT);
    const int nu = keep ? 544 : 512;
    for (int u = f.vcu; u < nu; u += f.G) {
        int b, h, row0, seq;
        if (u < 512) { b = u >> 7; const int rem = u & 127; h = rem >> 4; row0 = b * TS + CTXL + (rem & 15) * 256; seq = TS; }
        else { const int uc = u - 512; b = uc >> 3; h = uc & 7; row0 = b * TS; seq = CTXL; }
        int t2 = f.tid; asm volatile("" : "+v"(t2));
        att::attn_unit(QB + (size_t)row0 * 1024 + h * 128, KB + (size_t)b * TS * 256 + (h >> 2) * 128, VB + (size_t)b * TS * 256 + (h >> 2) * 128, AT + (size_t)row0 * 1024 + h * 128, seq, (char*)f.lds, t2);
    }
}
struct SchedPool { static constexpr bool GATHER = false; const char* A; const char* B; int G, c, nM; bool keep;
    __device__ __forceinline__ bool next(int i, pg8::Unit& u) const { const int L = i * G + c; if (L >= nM * 4) return false; const int pm = panel_of(L >> 2, keep), g = L & 3;
        u.A = A + ((size_t)pm * 256 * 1024 + g * 256) * 2; u.B = B + (size_t)g * 65536 * 2; u.pm = pm; u.pn = g; u.aux = g * 256; return true; }
};
namespace rk {
constexpr int LST = 144, MSZ = 64 * LST;
enum { M_AT = 0, M_BT, M_KT, M_RT, M_VT, M_MTAK, M_NTRB, M_NTRK, M_P0, M_P1, M_T0, M_T1, M_Q0, M_AP, M_PP, M_CNT };
constexpr int OFF_GC = M_CNT * MSZ, OFF_SEG = OFF_GC + 256;
struct Fr2 { bf16x8 a, b; };
__device__ __forceinline__ Fr2 rfr(LAS unsigned char* M, int t, int fr, int fq) { Fr2 r; const LAS unsigned char* p = M + (16 * t + fr) * LST + 16 * fq; r.a = *(const LAS bf16x8*)p; r.b = *(const LAS bf16x8*)(p + 64); return r; }
__device__ __forceinline__ Fr2 cfr(LAS unsigned char* M, int t, int lane) {
    const unsigned ad = (unsigned)(uintptr_t)M + (unsigned)((8 * (lane >> 4) + ((lane & 15) >> 2)) * LST + (16 * t + 4 * (lane & 3)) * 2);
    s16x4 a0, a1, b0, b1;
    asm volatile("ds_read_b64_tr_b16 %0, %4\n\tds_read_b64_tr_b16 %1, %4 offset:576\n\tds_read_b64_tr_b16 %2, %4 offset:4608\n\tds_read_b64_tr_b16 %3, %4 offset:5184\n\ts_waitcnt lgkmcnt(0)"
                 : "=&v"(a0), "=&v"(a1), "=&v"(b0), "=&v"(b1) : "v"(ad) : "memory");
    Fr2 r; r.a = (bf16x8){a0[0], a0[1], a0[2], a0[3], a1[0], a1[1], a1[2], a1[3]}; r.b = (bf16x8){b0[0], b0[1], b0[2], b0[3], b1[0], b1[1], b1[2], b1[3]}; return r;
}
__device__ __forceinline__ bf16x8 rfa(LAS unsigned char* M, int t, int fr, int fq) { return *(const LAS bf16x8*)(M + (16 * t + fr) * LST + 16 * fq); }
__device__ __forceinline__ void cfr2a(LAS unsigned char* M, int lane, bf16x8 (&o)[2]) {
    const unsigned ad = (unsigned)(uintptr_t)M + (unsigned)((8 * (lane >> 4) + ((lane & 15) >> 2)) * LST + (4 * (lane & 3)) * 2);
    s16x4 r[4];
    asm volatile("ds_read_b64_tr_b16 %0, %4\n\tds_read_b64_tr_b16 %1, %4 offset:576\n\tds_read_b64_tr_b16 %2, %4 offset:32\n\tds_read_b64_tr_b16 %3, %4 offset:608\n\ts_waitcnt lgkmcnt(0)"
                 : "=&v"(r[0]), "=&v"(r[1]), "=&v"(r[2]), "=&v"(r[3]) : "v"(ad) : "memory");
#pragma unroll
    for (int t = 0; t < 2; ++t) o[t] = (bf16x8){r[2 * t][0], r[2 * t][1], r[2 * t][2], r[2 * t][3], r[2 * t + 1][0], r[2 * t + 1][1], r[2 * t + 1][2], r[2 * t + 1][3]};
}
__device__ __forceinline__ void cfr4a(LAS unsigned char* M, int lane, bf16x8 (&o)[4]) {
    const unsigned ad = (unsigned)(uintptr_t)M + (unsigned)((8 * (lane >> 4) + ((lane & 15) >> 2)) * LST + (4 * (lane & 3)) * 2);
    s16x4 r[8];
    asm volatile("ds_read_b64_tr_b16 %0, %8\n\tds_read_b64_tr_b16 %1, %8 offset:576\n\tds_read_b64_tr_b16 %2, %8 offset:32\n\tds_read_b64_tr_b16 %3, %8 offset:608\n\t"
                 "ds_read_b64_tr_b16 %4, %8 offset:64\n\tds_read_b64_tr_b16 %5, %8 offset:640\n\tds_read_b64_tr_b16 %6, %8 offset:96\n\tds_read_b64_tr_b16 %7, %8 offset:672\n\ts_waitcnt lgkmcnt(0)"
                 : "=&v"(r[0]), "=&v"(r[1]), "=&v"(r[2]), "=&v"(r[3]), "=&v"(r[4]), "=&v"(r[5]), "=&v"(r[6]), "=&v"(r[7]) : "v"(ad) : "memory");
#pragma unroll
    for (int t = 0; t < 4; ++t) o[t] = (bf16x8){r[2 * t][0], r[2 * t][1], r[2 * t][2], r[2 * t][3], r[2 * t + 1][0], r[2 * t + 1][1], r[2 * t + 1][2], r[2 * t + 1][3]};
}
__device__ __forceinline__ void cfr4(LAS unsigned char* M, int lane, Fr2 (&o)[4]) {
    const unsigned ad = (unsigned)(uintptr_t)M + (unsigned)((8 * (lane >> 4) + ((lane & 15) >> 2)) * LST + (4 * (lane & 3)) * 2);
    s16x4 r[16];
    asm volatile("ds_read_b64_tr_b16 %0, %16\n\tds_read_b64_tr_b16 %1, %16 offset:576\n\tds_read_b64_tr_b16 %2, %16 offset:4608\n\tds_read_b64_tr_b16 %3, %16 offset:5184\n\t"
                 "ds_read_b64_tr_b16 %4, %16 offset:32\n\tds_read_b64_tr_b16 %5, %16 offset:608\n\tds_read_b64_tr_b16 %6, %16 offset:4640\n\tds_read_b64_tr_b16 %7, %16 offset:5216\n\t"
                 "ds_read_b64_tr_b16 %8, %16 offset:64\n\tds_read_b64_tr_b16 %9, %16 offset:640\n\tds_read_b64_tr_b16 %10, %16 offset:4672\n\tds_read_b64_tr_b16 %11, %16 offset:5248\n\t"
                 "ds_read_b64_tr_b16 %12, %16 offset:96\n\tds_read_b64_tr_b16 %13, %16 offset:672\n\tds_read_b64_tr_b16 %14, %16 offset:4704\n\tds_read_b64_tr_b16 %15, %16 offset:5280\n\ts_waitcnt lgkmcnt(0)"
                 : "=&v"(r[0]), "=&v"(r[1]), "=&v"(r[2]), "=&v"(r[3]), "=&v"(r[4]), "=&v"(r[5]), "=&v"(r[6]), "=&v"(r[7]), "=&v"(r[8]), "=&v"(r[9]), "=&v"(r[10]), "=&v"(r[11]), "=&v"(r[12]), "=&v"(r[13]), "=&v"(r[14]), "=&v"(r[15])
                 : "v"(ad) : "memory");
#pragma unroll
    for (int t = 0; t < 4; ++t) { o[t].a = (bf16x8){r[4 * t][0], r[4 * t][1], r[4 * t][2], r[4 * t][3], r[4 * t + 1][0], r[4 * t + 1][1], r[4 * t + 1][2], r[4 * t + 1][3]};
        o[t].b = (bf16x8){r[4 * t + 2][0], r[4 * t + 2][1], r[4 * t + 2][2], r[4 * t + 2][3], r[4 * t + 3][0], r[4 * t + 3][1], r[4 * t + 3][2], r[4 * t + 3][3]}; }
}
__device__ __forceinline__ f32x4 mm2(const Fr2& first, const Fr2& second, f32x4 acc) { acc = __builtin_amdgcn_mfma_f32_16x16x32_bf16(first.a, second.a, acc, 0, 0, 0); return __builtin_amdgcn_mfma_f32_16x16x32_bf16(first.b, second.b, acc, 0, 0, 0); }
__device__ __forceinline__ int tok_row(int b, int z, int c, int x) { const int p = 64 * c + x; const int t = (z == 0) ? p : (c < 4 ? (CTXL - 1 - p) : (TS + CTXL - 1 - p)); return b * TS + t; }
}
__device__ __forceinline__ void phase_scanA(const F& f0, int l) {
    using namespace rk;
    const F f = refresh(f0);
    const ArgView& a = *f.a; const unsigned char* wb = f.ws + WS_WB + (size_t)l * WB_BYTES;
    unsigned char* T = f.ws + WS_T; float* WD = (float*)(T + T_WD); bf16_t* KD = (bf16_t*)(T + T_KD); bf16_t* BD = (bf16_t*)(T + T_BD); const bf16_t* KK = (const bf16_t*)(T + T_KK);
    const bf16_t* RR = (const bf16_t*)(T + T_RR); const bf16_t* VV = (const bf16_t*)(T + T_VV); const bf16_t* KS = (const bf16_t*)(T + T_KS); const bf16_t* LA = (const bf16_t*)(T + T_LA);
    float* BON = (float*)(f.ws + WS_BON);
    LAS unsigned char* L = f.lds; LAS float* gC = (LAS float*)(L + OFF_GC); LAS float* seg = (LAS float*)(L + OFF_SEG); LAS float* cvec = (LAS float*)(L + OFF_SEG + 2048);
    const int w = f.wave;
    constexpr int NU = NBATCH * RWH * 2 * 68;
    const int u0 = (int)((long)f.vcu * NU / f.G), per = (int)((long)(f.vcu + 1) * NU / f.G) - u0;
    unsigned nkk[4], nrr[4], nvv[4]; bf16x8 nla[2]; u32x2 nks[4], nk2[4], nr2[4];
#define SA_LOAD(u_) do { const int ci_ = (u_) / 68, c_ = (u_) % 68, b_ = ci_ >> 5, h_ = (ci_ >> 1) & 15, z_ = ci_ & 1; \
          \
        { unsigned o_ = ((unsigned)tok_row(b_, z_, c_, 8 * w + 4 * (f.lane >> 5)) * 1024u + (unsigned)(h_ * 64 + 2 * (f.lane & 31))) * 2u; const unsigned st_ = z_ ? 0u - 2048u : 2048u; \
          _Pragma("unroll") for (int e = 0; e < 4; ++e) { nkk[e] = *(const unsigned*)((const char*)KK + o_); nrr[e] = *(const unsigned*)((const char*)RR + o_); nvv[e] = *(const unsigned*)((const char*)VV + o_); o_ += st_; } } \
        { const unsigned rowt_ = (unsigned)tok_row(b_, z_, c_, 16 * (w & 3) + (f.lane & 15)); const unsigned lo_ = (rowt_ * (unsigned)LA_W + (unsigned)(((w >> 2) ? 128 : 0) + z_ * 64 + 8 * (f.lane >> 4))) * 2u; \
          nla[0] = *(const bf16x8*)((const char*)LA + lo_); nla[1] = *(const bf16x8*)((const char*)LA + lo_ + 64u); \
          if (w >= 4) { const unsigned eo_ = (rowt_ * 1024u + (unsigned)(h_ * 64 + 4 * (f.lane >> 4))) * 2u; \
              _Pragma("unroll") for (int ft = 0; ft < 4; ++ft) { nks[ft] = *(const u32x2*)((const char*)KS + eo_ + 32u * ft); nk2[ft] = *(const u32x2*)((const char*)KK + eo_ + 32u * ft); nr2[ft] = *(const u32x2*)((const char*)RR + eo_ + 32u * ft); } } } } while (0)
    if (per > 0) SA_LOAD(u0);
#define SA_CLAIM() do { _Pragma("unroll") for (int e = 0; e < 4; ++e) asm volatile("" : "+v"(nkk[e]), "+v"(nrr[e]), "+v"(nvv[e])); asm volatile("" : "+v"(nla[0]), "+v"(nla[1])); \
        _Pragma("unroll") for (int ft = 0; ft < 4; ++ft) asm volatile("" : "+v"(nks[ft]), "+v"(nk2[ft]), "+v"(nr2[ft])); } while (0)
    SA_CLAIM();
    int cur_ci = -1;
    for (int k = 0; k < per; ++k) { const int u = u0 + k;
        const int ci = u / 68, c = u % 68, b = ci >> 5, h = (ci >> 1) & 15, z = ci & 1;
        int lane = f.lane; asm volatile("" : "+v"(lane));
        const int fr = lane & 15, fq = lane >> 4;
        if (ci != cur_ci) {
            cur_ci = ci; __syncthreads();
            for (int i = f.tid; i < 2 * 64 * 8; i += NTHR) { const int m = i >> 9, n = (i >> 3) & 63, cch = i & 7;
                *(LAS u32x4*)(L + (m ? M_PP : M_AP) * MSZ + n * LST + cch * 16) = *(const u32x4*)((const bf16_t*)(wb + (m ? WB_A2 : WB_W2)) + ((size_t)z * 1024 + h * 64 + n) * 64 + cch * 8); }
            if (f.tid < 256) { const int q = f.tid >> 6, j = f.tid & 63; cvec[f.tid] = q == 0 ? a.in[I_W0][(size_t)(l * 2 + z) * 1024 + h * 64 + j] : q == 1 ? a.in[I_A0][(size_t)(l * 2 + z) * 1024 + h * 64 + j] : q == 2 ? a.in[I_KA][(size_t)l * 1024 + h * 64 + j] : a.in[I_RK][(size_t)l * 1024 + h * 64 + j]; }
            LDS_WAIT(); __syncthreads(); }
        { const int prod = w >> 2, st = w & 3; const size_t rowt = (size_t)tok_row(b, z, c, 16 * st + fr); Fr2 sec; sec.a = nla[0]; sec.b = nla[1]; float bon = 0.f;
          f32x4 acc4[4]; { Fr2 wf[4];
#pragma unroll
            for (int ft = 0; ft < 4; ++ft) wf[ft] = rfr(L + (prod ? M_PP : M_AP) * MSZ, ft, fr, fq);
#pragma unroll
            for (int ft = 0; ft < 4; ++ft) acc4[ft] = mm2(wf[ft], sec, (f32x4){0.f, 0.f, 0.f, 0.f}); }
          const int so0 = (16 * st + fr) * LST + 8 * fq;
          if (prod == 0) {
#pragma unroll
              for (int ft = 0; ft < 4; ++ft) { const f32x4 w0 = *(const LAS f32x4*)(cvec + 16 * ft + 4 * fq); f32x4 o;
#pragma unroll
                  for (int e = 0; e < 4; ++e) o[e] = -0.60653066f * sigmoidf_(w0[e] + acc4[ft][e]);
                  *(LAS u32x2*)(L + M_P1 * MSZ + so0 + 32 * ft) = pk4(o); } }
          else {
#pragma unroll
              for (int ft = 0; ft < 4; ++ft) { const int j0 = 16 * ft + 4 * fq; const f32x4 a0 = *(const LAS f32x4*)(cvec + 64 + j0), ka = *(const LAS f32x4*)(cvec + 128 + j0), rk4 = *(const LAS f32x4*)(cvec + 192 + j0);
                  const f32x4 kv = up4(nks[ft]), kkv = up4(nk2[ft]), rv = up4(nr2[ft]); f32x4 kd, bd;
#pragma unroll
                  for (int e = 0; e < 4; ++e) { const float av = sigmoidf_(a0[e] + acc4[ft][e]); kd[e] = kv[e] * (1.0f + (av - 1.0f) * ka[e]); bd[e] = kkv[e] * av; bon += rv[e] * kd[e] * rk4[e]; }
                  *(LAS u32x2*)(L + M_T1 * MSZ + so0 + 32 * ft) = pk4(kd); *(LAS u32x2*)(L + M_Q0 * MSZ + so0 + 32 * ft) = pk4(bd); }
              bon += __shfl_xor(bon, 16); bon += __shfl_xor(bon, 32); if (fq == 0) BON[((size_t)z * R + rowt) * 16 + h] = bon; } }
        LDS_WAIT(); __syncthreads();
        { const int jp = lane & 31, th = lane >> 5; float lw0[4], lw1[4]; unsigned kdw[4], bdw[4], kkw[4], rrw[4], vvw[4]; float run0 = 0.f, run1 = 0.f;
#pragma unroll
          for (int e = 0; e < 4; ++e) { const int so = (8 * w + 4 * th + e) * LST + jp * 4; const unsigned lww = *(const LAS unsigned*)(L + M_P1 * MSZ + so); lw0[e] = bflo(lww); lw1[e] = bfhi(lww);
              kdw[e] = *(const LAS unsigned*)(L + M_T1 * MSZ + so); bdw[e] = *(const LAS unsigned*)(L + M_Q0 * MSZ + so); kkw[e] = nkk[e]; rrw[e] = nrr[e]; vvw[e] = nvv[e]; }
          if (k + 1 < per) SA_LOAD(u + 1);
#pragma unroll
          for (int e = 0; e < 4; ++e) { run0 += lw0[e]; lw0[e] = run0; run1 += lw1[e]; lw1[e] = run1; }
          const float o0 = __shfl_xor(run0, 32), o1 = __shfl_xor(run1, 32);
          if (th) *(LAS f32x2*)(seg + w * 64 + 2 * jp) = (f32x2){run0 + o0, run1 + o1};
          LDS_WAIT(); __syncthreads();
          float offs0 = th ? o0 : 0.f, offs1 = th ? o1 : 0.f;
#pragma unroll
          for (int g = 0; g < 8; ++g) if (g < w) { const f32x2 sg = *(const LAS f32x2*)(seg + g * 64 + 2 * jp); offs0 += sg.x; offs1 += sg.y; }
          float ep0 = __expf(offs0), ep1 = __expf(offs1);
#pragma unroll
          for (int e = 0; e < 4; ++e) { const float Lc0 = offs0 + lw0[e], Lc1 = offs1 + lw1[e]; const float el0 = __expf(Lc0), el1 = __expf(Lc1), em0 = __expf(-Lc0), em1 = __expf(-Lc1); const int ro = (8 * w + 4 * th + e) * LST + jp * 4;
              *(LAS unsigned*)(L + M_AT * MSZ + ro) = pk2(-bflo(kkw[e]) * ep0, -bfhi(kkw[e]) * ep1); *(LAS unsigned*)(L + M_BT * MSZ + ro) = pk2(bflo(bdw[e]) * em0, bfhi(bdw[e]) * em1);
              *(LAS unsigned*)(L + M_KT * MSZ + ro) = pk2(bflo(kdw[e]) * em0, bfhi(kdw[e]) * em1); *(LAS unsigned*)(L + M_RT * MSZ + ro) = pk2(bflo(rrw[e]) * el0, bfhi(rrw[e]) * el1);
              *(LAS unsigned*)(L + M_VT * MSZ + ro) = vvw[e]; ep0 = el0; ep1 = el1; if (w == 7 && th == 1 && e == 3) *(LAS f32x2*)(gC + 2 * jp) = (f32x2){el0, el1}; }
        }
        LDS_WAIT(); __syncthreads();
        { const int mat = w >> 1, sh = w & 1; LAS unsigned char* Fm = L + ((mat & 1) ? M_KT : M_BT) * MSZ; LAS unsigned char* Sm = L + ((mat < 2) ? M_AT : M_RT) * MSZ;
          LAS unsigned char* dst = L + (mat == 0 ? M_P0 : mat == 1 ? M_MTAK : mat == 2 ? M_NTRB : M_NTRK) * MSZ;
          Fr2 ff[4];
#pragma unroll
          for (int ft = 0; ft < 4; ++ft) ff[ft] = rfr(Fm, ft, fr, fq);
#pragma unroll
          for (int s2 = 0; s2 < 2; ++s2) { const int st = 2 * sh + s2; const Fr2 sf = rfr(Sm, st, fr, fq); const int y = 16 * st + fr;
              const int d0 = y - 4 * fq, d = d0 + ((mat < 2) ? 0 : 1);
              const int ro = y * LST + 8 * fq;
#pragma unroll
              for (int ft = 0; ft < 4; ++ft) { f32x4 acc = mm2(ff[ft], sf, (f32x4){0.f, 0.f, 0.f, 0.f});
#pragma unroll
                  for (int e = 0; e < 4; ++e) acc[e] = (16 * ft + e < d) ? acc[e] : 0.f;
                  *(LAS u32x2*)(dst + ro + 32 * ft) = pk4(acc);
                  if (mat == 0) {
#pragma unroll
                      for (int e = 0; e < 4; ++e) acc[e] += (16 * ft + e == d0) ? 1.f : 0.f;
                      *(LAS u32x2*)(L + M_T0 * MSZ + ro + 32 * ft) = pk4(acc); } } }
        }
        LDS_WAIT(); __syncthreads();
#pragma unroll
        for (int lv = 0; lv < 6; ++lv) {
            LAS unsigned char* Pc = L + ((lv & 1) ? M_P1 : M_P0) * MSZ; LAS unsigned char* Pn = L + ((lv & 1) ? M_P0 : M_P1) * MSZ;
            LAS unsigned char* Tc = L + ((lv & 1) ? M_T0 : M_T1) * MSZ; LAS unsigned char* Tn = L + ((lv & 1) ? M_T1 : M_T0) * MSZ;
            const int st = w & 3;
            if (st < 2) {
                const f32x4 z4 = (f32x4){0.f, 0.f, 0.f, 0.f};
                if (w < 4) { if (lv < 5) { const bf16x8 sa = rfa(Pc, st, fr, fq); bf16x8 ca[2]; cfr2a(Pc, lane, ca);
                    if (lv == 0) {
#pragma unroll
                        for (int ft = 2; ft < 4; ++ft) *(LAS u32x2*)(Pn + (16 * st + fr) * LST + (16 * ft + 4 * fq) * 2) = (u32x2){0u, 0u}; }
#pragma unroll
                    for (int ft = 0; ft < 2; ++ft) { const f32x4 acc = __builtin_amdgcn_mfma_f32_16x16x32_bf16(ca[ft], sa, z4, 0, 0, 0); *(LAS u32x2*)(Pn + (16 * st + fr) * LST + (16 * ft + 4 * fq) * 2) = pk4(acc); } } }
                else if (lv == 0) { const bf16x8 sa = rfa(L + M_MTAK * MSZ, st, fr, fq); bf16x8 ca[4]; cfr4a(L + M_VT * MSZ, lane, ca);
#pragma unroll
                    for (int ft = 0; ft < 4; ++ft) { const f32x4 acc = __builtin_amdgcn_mfma_f32_16x16x32_bf16(ca[ft], sa, z4, 0, 0, 0); *(LAS u32x2*)(L + M_Q0 * MSZ + (16 * st + fr) * LST + (16 * ft + 4 * fq) * 2) = pk4(acc); } }
                else { LAS unsigned char* Tcur = (lv & 1) ? L + M_T0 * MSZ : L + M_T1 * MSZ; LAS unsigned char* Tnew = (lv & 1) ? L + M_T1 * MSZ : L + M_T0 * MSZ; const bf16x8 sa = rfa(Tcur, st, fr, fq); bf16x8 ca[2]; cfr2a(Pc, lane, ca);
#pragma unroll
                    for (int ft = 0; ft < 2; ++ft) { const int o = (16 * st + fr) * LST + (16 * ft + 4 * fq) * 2; const f32x4 acc = __builtin_amdgcn_mfma_f32_16x16x32_bf16(ca[ft], sa, up4(*(const LAS u32x2*)(Tcur + o)), 0, 0, 0); *(LAS u32x2*)(Tnew + o) = pk4(acc); } }
            } else
            if (w < 4) { if (lv < 5) { const Fr2 sf = rfr(Pc, st, fr, fq); Fr2 cf[4]; cfr4(Pc, lane, cf);
#pragma unroll
                for (int ft = 0; ft < 4; ++ft) { const f32x4 acc = mm2(cf[ft], sf, (f32x4){0.f, 0.f, 0.f, 0.f}); *(LAS u32x2*)(Pn + (16 * st + fr) * LST + (16 * ft + 4 * fq) * 2) = pk4(acc); } } }
            else if (lv == 0) { const Fr2 sf = rfr(L + M_MTAK * MSZ, st, fr, fq); Fr2 cf[4]; cfr4(L + M_VT * MSZ, lane, cf);
#pragma unroll
                for (int ft = 0; ft < 4; ++ft) { const f32x4 acc = mm2(cf[ft], sf, (f32x4){0.f, 0.f, 0.f, 0.f}); *(LAS u32x2*)(L + M_Q0 * MSZ + (16 * st + fr) * LST + (16 * ft + 4 * fq) * 2) = pk4(acc); } }
            else { LAS unsigned char* Tcur = (lv & 1) ? L + M_T0 * MSZ : L + M_T1 * MSZ; LAS unsigned char* Tnew = (lv & 1) ? L + M_T1 * MSZ : L + M_T0 * MSZ; const Fr2 sf = rfr(Tcur, st, fr, fq); Fr2 cf[4]; cfr4(Pc, lane, cf);
#pragma unroll
                for (int ft = 0; ft < 4; ++ft) { const int o = (16 * st + fr) * LST + (16 * ft + 4 * fq) * 2; const f32x4 acc = mm2(cf[ft], sf, up4(*(const LAS u32x2*)(Tcur + o))); *(LAS u32x2*)(Tnew + o) = pk4(acc); } }
            (void)Tc; (void)Tn;
            LDS_WAIT(); __syncthreads();
        }
        { const int st = w & 3; LAS unsigned char* X = L + ((w < 4) ? M_AT : M_Q0) * MSZ; LAS unsigned char* O = L + ((w < 4) ? M_P0 : M_T0) * MSZ;
          if (st < 2) { const bf16x8 sa = rfa(L + M_T1 * MSZ, st, fr, fq); bf16x8 ca[4]; cfr4a(X, lane, ca);
#pragma unroll
              for (int ft = 0; ft < 4; ++ft) { const f32x4 acc = __builtin_amdgcn_mfma_f32_16x16x32_bf16(ca[ft], sa, (f32x4){0.f, 0.f, 0.f, 0.f}, 0, 0, 0); *(LAS u32x2*)(O + (16 * st + fr) * LST + (16 * ft + 4 * fq) * 2) = pk4(acc); } }
          else { const Fr2 sf = rfr(L + M_T1 * MSZ, st, fr, fq); Fr2 cf[4]; cfr4(X, lane, cf);
#pragma unroll
              for (int ft = 0; ft < 4; ++ft) { const f32x4 acc = mm2(cf[ft], sf, (f32x4){0.f, 0.f, 0.f, 0.f}); *(LAS u32x2*)(O + (16 * st + fr) * LST + (16 * ft + 4 * fq) * 2) = pk4(acc); } } }
        LDS_WAIT(); __syncthreads();
        SA_CLAIM();
        { const int st = w & 3; const int y = 16 * st + fr; const size_t row = (size_t)tok_row(b, z, c, y), zr = (size_t)z * R + row;
          const Fr2 s1 = cfr(L + M_T0 * MSZ, st, lane), s2f = cfr(L + M_VT * MSZ, st, lane);
          if (w < 4) { const Fr2 sf = rfr(L + M_NTRB * MSZ, st, fr, fq); Fr2 ap[4]; cfr4(L + M_P0 * MSZ, lane, ap);
#pragma unroll
              for (int ft = 0; ft < 4; ++ft) { const f32x4 acc = mm2(ap[ft], sf, up4(*(const LAS u32x2*)(L + M_RT * MSZ + y * LST + (16 * ft + 4 * fq) * 2)));
                  *(u32x2*)(KD + zr * 1024 + h * 64 + 16 * ft + 4 * fq) = pk4(acc); }
#pragma unroll
              for (int ft = 0; ft < 4; ++ft) { f32x4 acc = mm2(rfr(L + M_NTRB * MSZ, ft, fr, fq), s1, (f32x4){0.f, 0.f, 0.f, 0.f}); acc = mm2(rfr(L + M_NTRK * MSZ, ft, fr, fq), s2f, acc);
                  *(u32x2*)(BD + zr * 1024 + h * 64 + 16 * ft + 4 * fq) = pk4(acc); } }
          else { const Fr2 sf = cfr(L + M_BT * MSZ, st, lane); const float g = gC[y]; Fr2 ap[4]; cfr4(L + M_P0 * MSZ, lane, ap);
#pragma unroll
              for (int ft = 0; ft < 4; ++ft) { f32x4 acc = mm2(ap[ft], sf, (f32x4){0.f, 0.f, 0.f, 0.f});
#pragma unroll
                  for (int e = 0; e < 4; ++e) acc[e] = g * (acc[e] + ((16 * ft + 4 * fq + e == y) ? 1.f : 0.f));
                  *(u32x2*)((bf16_t*)(WD + zr * 1024 + h * 64) + 16 * ft + 4 * fq) = pk4(acc); }
              Fr2 bt4[4], kt4[4]; cfr4(L + M_BT * MSZ, lane, bt4); cfr4(L + M_KT * MSZ, lane, kt4);
#pragma unroll
              for (int ft = 0; ft < 4; ++ft) { f32x4 acc = mm2(bt4[ft], s1, (f32x4){0.f, 0.f, 0.f, 0.f}); acc = mm2(kt4[ft], s2f, acc);
                  const f32x4 g4 = *(const LAS f32x4*)(gC + 16 * ft + 4 * fq);
                  *(u32x2*)((bf16_t*)(WD + zr * 1024 + h * 64) + 64 + 16 * ft + 4 * fq) = pk4(acc * g4); } }
        }
    }
    __syncthreads();
}
__device__ __forceinline__ void phase_scanB(const F& f0) {
    using namespace rk;
    const F f = refresh(f0);
    unsigned char* T = f.ws + WS_T; const unsigned char* WDb = (const unsigned char*)(T + T_WD); const unsigned char* KDb = (const unsigned char*)(T + T_KD); const unsigned char* BDb = (const unsigned char*)(T + T_BD);
    constexpr int NR = 5, SLOT = 24576, O_PHI = 0, O_RP = 8192, O_PSI = 16384, O_Y0 = 20480, NCH = 68;
    const int fr = f.lane & 15, fq = f.lane >> 4, w = f.wave;
    for (int task = f.vcu; task < NBATCH * RWH * 2 * 2; task += f.G) {
        const int ci = task >> 1, hq = task & 1, b = ci >> 5, h = (ci >> 1) & 15, z = ci & 1, sgn = z ? -1 : 1;
#define SB_ROW0(c_) (b * TS + ((z == 0) ? 64 * (c_) : ((c_) < 4 ? CTXL - 1 - 64 * (c_) : TS + CTXL - 1 - 64 * (c_))))
        int loff[4]; const int lr8 = f.lane >> 3, gch = ((f.lane & 7) ^ lr8) * 16;
#pragma unroll
        for (int k = 0; k < 4; ++k) { const int j = 4 * (w - 2) + k; int o;
            if (j < 8) o = sgn * (8 * j + lr8) * 4096 + gch; else if (j < 16) o = sgn * (8 * (j - 8) + lr8) * 2048 + gch;
            else if (j < 20) o = sgn * (32 * hq + 8 * (j - 16) + lr8) * 4096 + 128 + gch; else o = sgn * (32 * hq + 8 * (j - 20) + lr8) * 2048 + gch;
            loff[k] = o; }
#define SB_ISSUE(c_) do { const size_t zr0_ = (size_t)z * R + (size_t)SB_ROW0(c_); const unsigned char* wb_ = WDb + (zr0_ * 1024 + h * 64) * 4; const unsigned char* kb_ = KDb + (zr0_ * 1024 + h * 64) * 2; \
            const unsigned char* bb_ = BDb + (zr0_ * 1024 + h * 64) * 2; LAS unsigned char* sl_ = f.lds + ((c_) % NR) * SLOT; \
            _Pragma("unroll") for (int k = 0; k < 4; ++k) { const int j = 4 * (w - 2) + k; const unsigned char* gb_ = (j < 8) ? wb_ : (j < 16) ? kb_ : (j < 20) ? wb_ : bb_; \
                __builtin_amdgcn_global_load_lds((const unsigned*)(gb_ + loff[k]), (LAS unsigned*)(sl_ + j * 1024), 16, 0, 0); } } while (0)
        if (w >= 2) { SB_ISSUE(0); SB_ISSUE(1); SB_ISSUE(2); }
        const int q = 2 * hq + (w & 1), ri = 16 * (w & 1) + fr;
        unsigned char* Yb = (z == 0) ? (T + T_KK) : (T + T_MG);
        const int offY = sgn * fq * 4 * 2048 + fr * 2;
        f32x4 S[4];
#pragma unroll
        for (int mt = 0; mt < 4; ++mt) S[mt] = (f32x4){0.f, 0.f, 0.f, 0.f};
        for (int c = 0; c < NCH; ++c) {
            if (w >= 2) { if (c + 3 < NCH) { SB_ISSUE(c + 3); asm volatile("s_waitcnt vmcnt(12)" ::: "memory"); } else asm volatile("s_waitcnt vmcnt(0)" ::: "memory"); }
            asm volatile("s_waitcnt lgkmcnt(0)" ::: "memory"); __builtin_amdgcn_s_barrier(); asm volatile("" ::: "memory");
            if (w < 2) {
                const LAS unsigned char* sl = f.lds + (c % NR) * SLOT;
                bf16x8 sb[2];
#pragma unroll
                for (int ks = 0; ks < 2; ++ks) { u32x4 w4; w4.x = pk2(S[2 * ks][0], S[2 * ks][1]); w4.y = pk2(S[2 * ks][2], S[2 * ks][3]); w4.z = pk2(S[2 * ks + 1][0], S[2 * ks + 1][1]); w4.w = pk2(S[2 * ks + 1][2], S[2 * ks + 1][3]); sb[ks] = __builtin_bit_cast(bf16x8, w4); }
                unsigned char* yb = Yb + ((size_t)SB_ROW0(c) * 1024 + h * 64 + 16 * q) * 2;
#pragma unroll
                for (int mt = 0; mt < 4; ++mt) {
                    const int r = 16 * mt + fr, sw = r & 7, chs = 2 * mt + (fq >> 1), sub = (fq & 1) * 8;
                    f32x4 ya = up4(*(const LAS u32x2*)(sl + O_Y0 + ri * 128 + ((chs ^ (ri & 7)) * 16) + sub)), sa = up4(*(const LAS u32x2*)(sl + O_PSI + ri * 128 + ((chs ^ (ri & 7)) * 16) + sub));
#pragma unroll
                    for (int ks = 0; ks < 2; ++ks) { const int c0 = 4 * ks + (fq >> 1), c1 = c0 + 2;
                        const u32x2 r0 = *(const LAS u32x2*)(sl + O_RP + r * 128 + ((c0 ^ sw) * 16) + sub), r1 = *(const LAS u32x2*)(sl + O_RP + r * 128 + ((c1 ^ sw) * 16) + sub);
                        const u32x2 p0 = *(const LAS u32x2*)(sl + O_PHI + r * 128 + ((c0 ^ sw) * 16) + sub), p1 = *(const LAS u32x2*)(sl + O_PHI + r * 128 + ((c1 ^ sw) * 16) + sub);
                        u32x4 ar; ar.x = r0.x; ar.y = r0.y; ar.z = r1.x; ar.w = r1.y; u32x4 ap; ap.x = p0.x; ap.y = p0.y; ap.z = p1.x; ap.w = p1.y;
                        ya = __builtin_amdgcn_mfma_f32_16x16x32_bf16(__builtin_bit_cast(bf16x8, ar), sb[ks], ya, 0, 0, 0);
                        sa = __builtin_amdgcn_mfma_f32_16x16x32_bf16(__builtin_bit_cast(bf16x8, ap), sb[ks], sa, 0, 0, 0); }
#pragma unroll
                    for (int e = 0; e < 4; ++e) *(bf16_t*)(yb + (long)sgn * (16 * mt + e) * 2048 + offY) = f2bf(ya[e]);
                    S[mt] = sa;
                }
            }
        }
        asm volatile("s_waitcnt lgkmcnt(0)" ::: "memory"); __builtin_amdgcn_s_barrier(); asm volatile("" ::: "memory");
#undef SB_ISSUE
#undef SB_ROW0
    }
}
__device__ __forceinline__ void phase_rwkv_post(const F& f0, int l, bool keep) {
    const F f = refresh(f0);
    const ArgView& a = *f.a; unsigned char* T = f.ws + WS_T; const unsigned char* wb = f.ws + WS_WB + (size_t)l * WB_BYTES;
    const bf16_t* Y = (const bf16_t*)(T + T_KK); const bf16_t* Y1 = (const bf16_t*)(T + T_MG); const bf16_t* VV = (const bf16_t*)(T + T_VV); const float* BON = (const float*)(f.ws + WS_BON); bf16_t* RWo = (bf16_t*)(T + T_RW);
    const int cb = f.vcu & 15, rg = f.vcu >> 4, ngrp = f.G >> 4;
    for (int i = f.tid; i < 64 * 40; i += NTHR) { const int n = i / 40, c = i % 40; *(LAS u32x4*)(f.lds + n * lr::P320 + c * 16) = *(const u32x4*)((const bf16_t*)(wb + WB_G2) + (size_t)(cb * 64 + n) * 320 + c * 8); }
    LDS_WAIT(); __syncthreads();
    f32x4 lw4[4], lb4[4];
    { const int fq0 = f.lane >> 4;
#pragma unroll
      for (int nt = 0; nt < 4; ++nt) { lw4[nt] = *(const f32x4*)(a.in[I_LNW] + (size_t)l * 1024 + cb * 64 + 16 * nt + 4 * fq0); lb4[nt] = *(const f32x4*)(a.in[I_LNB] + (size_t)l * 1024 + cb * 64 + 16 * nt + 4 * fq0); } }
    for (int t = rg + ngrp * f.wave; t < R / 16; t += ngrp * NWAVES) {
        if (!keep && (t % (TS / 16)) < CTXL / 16) continue;
        int lane = f.lane; asm volatile("" : "+v"(lane));
        const int fr = lane & 15, fq = lane >> 4; const size_t row = (size_t)(t * 16 + fr), eo = row * 1024 + cb * 64 + 4 * fq;
        const bf16_t* LAp = (const bf16_t*)(T + T_LA) + row * LA_W + 256 + 8 * fq;
        bf16x8 afa[10]; u32x2 y0[4], y1[4], v4[4];
#pragma unroll
        for (int i = 0; i < 10; ++i) afa[i] = *(const bf16x8*)(LAp + 32 * i);
#pragma unroll
        for (int nt = 0; nt < 4; ++nt) { y0[nt] = *(const u32x2*)(Y + eo + 16 * nt); y1[nt] = *(const u32x2*)(Y1 + eo + 16 * nt); v4[nt] = *(const u32x2*)(VV + eo + 16 * nt); }
        const float bonus = BON[row * 16 + cb] + BON[((size_t)R + row) * 16 + cb];
        f32x4 gg[4], yy[4]; float s1 = 0.f;
#pragma unroll
        for (int nt = 0; nt < 4; ++nt) { f32x4 acc = (f32x4){0.f, 0.f, 0.f, 0.f};
#pragma unroll
            for (int ks = 0; ks < 10; ++ks) acc = __builtin_amdgcn_mfma_f32_16x16x32_bf16(*(const LAS bf16x8*)(f.lds + (16 * nt + fr) * lr::P320 + (32 * ks + 8 * fq) * 2), afa[ks], acc, 0, 0, 0);
            gg[nt] = acc; yy[nt] = rk::up4(y0[nt]) + rk::up4(y1[nt]); s1 += (yy[nt][0] + yy[nt][1]) + (yy[nt][2] + yy[nt][3]); }
        s1 += __shfl_xor(s1, 16); s1 += __shfl_xor(s1, 32); const float mean = s1 * (1.0f / 64.0f); float q2 = 0.f;
#pragma unroll
        for (int nt = 0; nt < 4; ++nt) { const f32x4 d = yy[nt] - mean; q2 += (d[0] * d[0] + d[1] * d[1]) + (d[2] * d[2] + d[3] * d[3]); }
        q2 += __shfl_xor(q2, 16); q2 += __shfl_xor(q2, 32); const float rstd = rsqrtf(q2 * (1.0f / 64.0f) + GN_EPS);
#pragma unroll
        for (int nt = 0; nt < 4; ++nt) { const f32x4 yn = (yy[nt] - mean) * rstd * lw4[nt] + lb4[nt]; const f32x4 o = (yn + rk::up4(v4[nt]) * bonus) * gg[nt]; *(u32x2*)(RWo + eo + 16 * nt) = rk::pk4(o); }
    }
}

struct SchedMerge { static constexpr bool GATHER = false; const char *A0, *B0; int G, c, nM; bool keep;
    __device__ __forceinline__ bool next(int i, pg8::Unit& u) const { const int tile = (i / 3) * G + c, seg = i % 3; if (tile >= nM * 8) return false; int pm, pn; pg8::tile_of(tile, nM, 8, pm, pn); pm = panel_of(pm, keep);
        u.A = A0 + (size_t)seg * ((size_t)R * 1024 * 2) + (size_t)pm * 256 * 1024 * 2; u.B = B0 + (size_t)seg * ((size_t)2048 * 1024 * 2) + (size_t)pn * 256 * 1024 * 2; u.pm = pm; u.pn = pn; u.aux = seg; return true; }
};
struct EpiMerge { const bf16_t* PG; bf16_t* MG;
    __device__ __forceinline__ bool operator()(pg8::Acc& acc, const pg8::Unit& u, int wr, int wc, int fr, int fq) const {
        asm volatile("" : "+v"(fr), "+v"(fq));
        const int seg = u.aux;
        const bf16_t* ta = PG + (((size_t)u.pm * 24 + (seg * 8 + u.pn)) * 8 + (wr * 4 + wc)) * (16 * 64 * 8) + (fq * 16 + fr) * 8;
        const bf16_t* tb = ta + (size_t)8 * 8 * (16 * 64 * 8);
#pragma unroll
        for (int hb = 0; hb < 4; ++hb) { const int ai = hb >> 1, q0 = (hb & 1) * 4;
            u32x4 ga[4], gb[4];
#pragma unroll
            for (int q = 0; q < 4; ++q) ga[q] = *(const u32x4*)(ta + (ai * 8 + q0 + q) * (64 * 8));
            if (seg < 2) {
#pragma unroll
                for (int q = 0; q < 4; ++q) gb[q] = *(const u32x4*)(tb + (ai * 8 + q0 + q) * (64 * 8)); }
            asm volatile("" ::: "memory");
#pragma unroll
            for (int q = 0; q < 4; ++q) { const int m = (q0 + q) >> 1, bj = (q0 + q) & 1; float sa[8], mlt[8];
                sa[0] = bflo(ga[q].x); sa[1] = bfhi(ga[q].x); sa[2] = bflo(ga[q].y); sa[3] = bfhi(ga[q].y); sa[4] = bflo(ga[q].z); sa[5] = bfhi(ga[q].z); sa[6] = bflo(ga[q].w); sa[7] = bfhi(ga[q].w);
                if (seg < 2) { float sb[8]; sb[0] = bflo(gb[q].x); sb[1] = bfhi(gb[q].x); sb[2] = bflo(gb[q].y); sb[3] = bfhi(gb[q].y); sb[4] = bflo(gb[q].z); sb[5] = bfhi(gb[q].z); sb[6] = bflo(gb[q].w); sb[7] = bfhi(gb[q].w);
#pragma unroll
                    for (int j = 0; j < 8; ++j) mlt[j] = sb[j] * __builtin_amdgcn_rcpf(sa[j]); }
                else {
#pragma unroll
                    for (int j = 0; j < 8; ++j) mlt[j] = __builtin_amdgcn_rcpf(sa[j]); }
                acc[ai][bj][m][0] *= (f32x4){mlt[0], mlt[1], mlt[2], mlt[3]}; acc[ai][bj][m][1] *= (f32x4){mlt[4], mlt[5], mlt[6], mlt[7]}; }
            if (seg == 2) {
#pragma unroll
                for (int q = 0; q < 4; ++q) { const int m = (q0 + q) >> 1, bj = (q0 + q) & 1; pg8::st8(MG + (size_t)(u.pm * 256 + 128 * ai + 64 * wr + 16 * m + fr) * D + u.pn * 256 + 128 * bj + 32 * wc + 8 * fq, acc[ai][bj][m][0], acc[ai][bj][m][1]); } }
        }
        return seg < 2; }
};

__device__ __forceinline__ unsigned char* moe_w(const F& f, int l) { return l == 0 ? f.ws + WS_T + T_WGU : f.ws + WS_MOE1; }
__device__ __forceinline__ void cvt_moe(const F& f, int l, int vgw, int vngw, int parts = 15) {
    const ArgView& a = *f.a; int off = 0; unsigned char* wgu = moe_w(f, l); unsigned char* wdn = wgu + MOE_WGU_BYTES;
    if (parts & 1) cvt_T<2>(f, a.in[I_WEG] + (size_t)l * NE * 2048 * 1024, NE, 2048, 1024, (bf16_t*)wgu, 2048, off, vgw, vngw);
    if (parts & 2) cvt_T<3>(f, a.in[I_WEU] + (size_t)l * NE * 2048 * 1024, NE / 2, 2048, 1024, (bf16_t*)wgu, 2048, off, vgw, vngw);
    if (parts & 8) cvt_T<3>(f, a.in[I_WEU] + ((size_t)l * NE + NE / 2) * 2048 * 1024, NE / 2, 2048, 1024, (bf16_t*)wgu + (size_t)(NE / 2) * 2048 * 2048, 2048, off, vgw, vngw);
    if (parts & 4) cvt_T<0>(f, a.in[I_WED] + (size_t)l * NE * 1024 * 2048, NE, 1024, 2048, (bf16_t*)wdn, 2048, off, vgw, vngw);
}
__device__ __forceinline__ int tail_rank(int tiles, int G, int& n_idle) { const int extra = tiles % G; n_idle = G - extra; return (extra > 0 && (int)blockIdx.x >= extra) ? (int)blockIdx.x - extra : -1; }
__device__ __forceinline__ void phase_resid1(const F& f0, int l, bool keep) {
    const F f = refresh(f0);
    const ArgView& a = *f.a; unsigned char* T = f.ws + WS_T; bf16_t* XS = (bf16_t*)(f.ws + WS_XS); bf16_t* H = (bf16_t*)(f.ws + WS_H); const bf16_t* MX = (const bf16_t*)(T + T_MX); float* AFF = (float*)(f.ws + WS_AFF);
    LAS float* WR = (LAS float*)f.lds;
    { const float* wr = a.in[I_WRT] + (size_t)l * 2048 * 16;
      for (int i = f.tid; i < 2048 * 4; i += NTHR) { const int k = i >> 2, q = i & 3; const f32x4 w = *(const f32x4*)(wr + k * 16 + q * 4);
          WR[(4 * q + 0) * 2048 + k] = w.x; WR[(4 * q + 1) * 2048 + k] = w.y; WR[(4 * q + 2) * 2048 + k] = w.z; WR[(4 * q + 3) * 2048 + k] = w.w; } }
    __syncthreads();
    const int nrows = keep ? R : NBATCH * SEQ;
    for (int idx = f.gw; idx < nrows; idx += f.NGW) { const int row = row_of(idx, keep);
        f32x4 mx[8], xs[8], y[8]; row_ld_bf16(MX + (size_t)row * D, mx, f.lane);
        if (l == 0) { const int b = row / TS, t = row % TS; row_ld_f32((t < CTXL) ? a.in[I_CTX] + ((size_t)b * CTXL + t) * D : a.in[I_X] + ((size_t)b * SEQ + (t - CTXL)) * D, xs, f.lane); } else row_ld_bf16(XS + (size_t)row * D, xs, f.lane);
        const float rstd = row_rstd(mx); const float* np0 = a.in[I_NPOST] + (size_t)(l * 2 + 0) * D; const float* g2 = mod_vec(f, l, row, 2);
        { f32x4 gv[8], nv[8];
#pragma unroll
          for (int j = 0; j < 8; ++j) { const int e = (j * 64 + f.lane) * 4; gv[j] = *(const f32x4*)(g2 + e); nv[j] = *(const f32x4*)(np0 + e); }
#pragma unroll
          for (int j = 0; j < 8; ++j) xs[j] = xs[j] + gv[j] * (mx[j] * rstd * nv[j]); }
        row_st_bf16(XS + (size_t)row * D, xs, f.lane);
        const float rstd2 = row_rstd(xs);
        row_modnorm(xs, rstd2, a.in[I_NPRE] + (size_t)(l * 2 + 1) * D, mod_vec(f, l, row, 3), mod_vec(f, l, row, 4), y, f.lane);
        row_st_bf16(H + (size_t)row * D, y, f.lane);
        float lg[16];
#pragma unroll
        for (int ex = 0; ex < 16; ++ex) { float s = 0.f;
#pragma unroll
            for (int j = 0; j < 8; ++j) { const f32x4 w = *(const LAS f32x4*)(WR + ex * 2048 + (j * 64 + f.lane) * 4); s += (y[j].x * w.x + y[j].y * w.y) + (y[j].z * w.z + y[j].w * w.w); }
            lg[ex] = wave_sum(s); }
        float mxl = lg[0];
#pragma unroll
        for (int ex = 1; ex < 16; ++ex) mxl = fmaxf(mxl, lg[ex]);
        float den = 0.f;
#pragma unroll
        for (int ex = 0; ex < 16; ++ex) { lg[ex] = __expf(lg[ex] - mxl); den += lg[ex]; }
        const float rd = 1.0f / den; float mine = 0.f;
#pragma unroll
        for (int ex = 0; ex < 16; ++ex) mine = (f.lane == ex) ? lg[ex] * rd : mine;
        if (f.lane < 16) AFF[(size_t)row * 16 + f.lane] = mine;
    }
}

__device__ __forceinline__ void phase_route(const F& f0, bool keep) {
    const F f = refresh(f0);
    const float* AFF = (const float*)(f.ws + WS_AFF); int* TOKSLOT = (int*)(f.ws + WS_TOKSLOT); int* SLOTROW = (int*)(f.ws + WS_SLOTROW);
    LAS unsigned* hist = (LAS unsigned*)f.lds; LAS unsigned* ctl = hist + 256; LAS unsigned* wsum = hist + 320;
    const int nl = keep ? 128 : 64;
    for (int li = f.vcu; li < nl; li += f.G) {
        int b, e, n, cap, row0, slot0;
        if (li < 64) { b = li >> 4; e = li & 15; n = SEQ; cap = CAP_L; row0 = b * TS + CTXL; slot0 = e * ESLOTS + b * CAP_L; }
        else { const int lc = li - 64; b = lc >> 4; e = lc & 15; n = CTXL; cap = CAP_C; row0 = b * TS; slot0 = e * ESLOTS + NBATCH * CAP_L + b * CAP_C; }
        unsigned key[8]; const int i0 = f.tid * 8;
#pragma unroll
        for (int j = 0; j < 8; ++j) key[j] = (i0 + j < n) ? __float_as_uint(AFF[(size_t)(row0 + i0 + j) * 16 + e]) : 0u;
        unsigned prefix = 0u, remaining = (unsigned)cap;
#pragma unroll
        for (int pass = 0; pass < 4; ++pass) { const int sh = 24 - 8 * pass; const unsigned himask = pass == 0 ? 0u : (0xffffffffu << (sh + 8));
            if (f.tid < 256) hist[f.tid] = 0u;
            __syncthreads();
#pragma unroll
            for (int j = 0; j < 8; ++j) if (i0 + j < n && (key[j] & himask) == prefix) atomicAdd((unsigned*)&hist[(key[j] >> sh) & 255u], 1u);
            __syncthreads();
            if (f.tid < 64) {
                unsigned h4[4]; unsigned s = 0u;
#pragma unroll
                for (int q = 0; q < 4; ++q) { h4[q] = hist[f.tid * 4 + q]; s += h4[q]; }
                unsigned suf = s;
#pragma unroll
                for (int o = 1; o < 64; o <<= 1) { const unsigned t = __shfl_down(suf, o); if (f.lane + o < 64) suf += t; }
                unsigned acc = suf - s; int found = -1; unsigned rem_new = 0u;
#pragma unroll
                for (int q = 3; q >= 0; --q) { if (found < 0 && acc < remaining && acc + h4[q] >= remaining) { found = f.tid * 4 + q; rem_new = remaining - acc; } acc += h4[q]; }
                if (found >= 0) { ctl[0] = prefix | ((unsigned)found << sh); ctl[1] = rem_new; }
            }
            __syncthreads();
            prefix = ctl[0]; remaining = ctl[1];
            __syncthreads();
        }
        unsigned gt = 0u, eq = 0u;
#pragma unroll
        for (int j = 0; j < 8; ++j) { if (i0 + j < n) { gt += key[j] > prefix ? 1u : 0u; eq += key[j] == prefix ? 1u : 0u; } }
        unsigned pg = gt, pe = eq;
#pragma unroll
        for (int o = 1; o < 64; o <<= 1) { const unsigned tg = __shfl_up(pg, o), te = __shfl_up(pe, o); if (f.lane >= o) { pg += tg; pe += te; } }
        if (f.lane == 63) { wsum[f.wave] = pg; wsum[8 + f.wave] = pe; }
        __syncthreads();
        unsigned bg = 0u, be = 0u;
#pragma unroll
        for (int w2 = 0; w2 < 8; ++w2) { if (w2 < f.wave) { bg += wsum[w2]; be += wsum[8 + w2]; } }
        unsigned cg = bg + pg - gt, ce = be + pe - eq;
#pragma unroll
        for (int j = 0; j < 8; ++j) { if (i0 + j < n) { const bool isg = key[j] > prefix, ise = key[j] == prefix; const bool sel = isg || (ise && ce < remaining);
                const unsigned taken_eq = ce < remaining ? ce : remaining;
                const int slot = slot0 + (int)(cg + taken_eq); const int row = row0 + i0 + j;
                TOKSLOT[(size_t)row * 16 + e] = sel ? slot : -1; if (sel) SLOTROW[slot] = row;
                cg += isg ? 1u : 0u; ce += ise ? 1u : 0u; } }
        __syncthreads();
    }
}
__device__ __forceinline__ void phase_gather(const F& f0, bool keep) {
    const F f = refresh(f0);
    unsigned char* T = f.ws + WS_T; const int* SLOTROW = (const int*)(f.ws + WS_SLOTROW); const bf16_t* H = (const bf16_t*)(f.ws + WS_H); bf16_t* XG = (bf16_t*)(T + T_XG);
    const int per = keep ? (NBATCH * CAP_L + NBATCH * CAP_C) : NBATCH * CAP_L;
    for (int i = f.gw; i < NE * per; i += f.NGW) { const int slot = (i / per) * ESLOTS + (i % per); const int row = SLOTROW[slot];
        const u32x4* src = (const u32x4*)(H + (size_t)row * D); u32x4* dst = (u32x4*)(XG + (size_t)slot * D);
#pragma unroll
        for (int j = 0; j < 4; ++j) dst[f.lane + 64 * j] = src[f.lane + 64 * j]; }
}

template <bool GA> struct SchedMoeT { static constexpr bool GATHER = GA; const char* A; const char* B; const int* idx; size_t a_row_bytes, b_tile, b_exp; int G, c, nrt;
    __device__ __forceinline__ bool next(int i, pg8::Unit& u) const { const int L = i * G + c; if (L >= NE * nrt * 8) return false; const int e = L / (nrt * 8), rem = L % (nrt * 8), rt = rem >> 3, pn = rem & 7;
        u.pm = e * 9 + rt; u.pn = pn; u.aux = pn * 256; u.A = GA ? A : A + (size_t)u.pm * 256 * a_row_bytes; u.gidx = idx + (size_t)u.pm * 256; u.B = B + (size_t)e * b_exp + (size_t)pn * b_tile; return true; }
};
struct EpiSilu { bf16_t* HID;
    __device__ __forceinline__ bool operator()(pg8::Acc& acc, const pg8::Unit& u, int wr, int wc, int fr, int fq) const {
        asm volatile("" : "+v"(fr), "+v"(fq));
#pragma unroll
        for (int ai = 0; ai < 2; ++ai)
#pragma unroll
            for (int m = 0; m < 4; ++m) { f32x4 o[2];
#pragma unroll
                for (int n = 0; n < 2; ++n)
#pragma unroll
                    for (int j = 0; j < 4; ++j) { const float g = acc[ai][0][m][n][j]; o[n][j] = g / (1.0f + __expf(-g)) * acc[ai][1][m][n][j]; }
                pg8::st8(HID + (size_t)(u.pm * 256 + 128 * ai + 64 * wr + 16 * m + fr) * FF + u.pn * 128 + 32 * wc + 8 * fq, o[0], o[1]); }
        return false; }
};

__device__ __forceinline__ void phase_resid2(const F& f0, int l, bool keep) {
    const F f = refresh(f0);
    const ArgView& a = *f.a; unsigned char* T = f.ws + WS_T; bf16_t* XS = (bf16_t*)(f.ws + WS_XS); const bf16_t* Y = (const bf16_t*)(T + T_Y); const float* AFF = (const float*)(f.ws + WS_AFF); const int* TOKSLOT = (const int*)(f.ws + WS_TOKSLOT);
    bf16_t* H = (bf16_t*)(f.ws + WS_H);
    const int nrows = keep ? R : NBATCH * SEQ;
    LAS float* lv = (LAS float*)f.lds;
    const int c0 = (int)((long)f.vcu * nrows / f.G), c1 = (int)((long)(f.vcu + 1) * nrows / f.G);
    for (int s0 = c0; s0 < c1; ) {
        const int rowS = row_of(s0, keep), bS = rowS / TS, tS = rowS % TS; const int nextb = keep ? ((tS < CTXL) ? rowS - tS + CTXL : rowS - tS + TS) : ((s0 >> 12) + 1) * SEQ;
        const int s1 = nextb < c1 ? nextb : c1;
        __syncthreads();
        { const float* v0 = mod_vec(f, l, rowS, 5); const float* v1 = a.in[I_NPOST] + (size_t)(l * 2 + 1) * D;
          const float* v2 = a.in[I_NPRE] + (size_t)((l < DEPTH - 1 ? l + 1 : l) * 2 + 0) * D; const float* v3 = mod_vec(f, l < DEPTH - 1 ? l + 1 : l, rowS, 0); const float* v4 = mod_vec(f, l < DEPTH - 1 ? l + 1 : l, rowS, 1);
          for (int i = f.tid; i < 2048 / 4; i += NTHR) { *(LAS f32x4*)(lv + 4 * i) = *(const f32x4*)(v0 + 4 * i); *(LAS f32x4*)(lv + 2048 + 4 * i) = *(const f32x4*)(v1 + 4 * i);
              *(LAS f32x4*)(lv + 4096 + 4 * i) = *(const f32x4*)(v2 + 4 * i); *(LAS f32x4*)(lv + 6144 + 4 * i) = *(const f32x4*)(v3 + 4 * i); *(LAS f32x4*)(lv + 8192 + 4 * i) = *(const f32x4*)(v4 + 4 * i); } }
        (void)bS; LDS_WAIT(); __syncthreads();
        for (int idx = s0 + f.wave; idx < s1; idx += NWAVES) { const int row = row_of(idx, keep);
            const int myslot = (f.lane < 16) ? TOKSLOT[(size_t)row * 16 + f.lane] : -1; const float myaff = (f.lane < 16) ? AFF[(size_t)row * 16 + f.lane] : 0.f;
            unsigned long long mask = __ballot(myslot >= 0);
            f32x4 acc[8], xs[8];
            row_ld_bf16(XS + (size_t)row * D, xs, f.lane);
#pragma unroll
            for (int j = 0; j < 8; ++j) acc[j] = (f32x4){0.f, 0.f, 0.f, 0.f};
            while (mask) {
                const int e0 = __builtin_ctzll(mask); mask &= mask - 1; const int e1 = mask ? __builtin_ctzll(mask) : e0; const bool two = mask != 0ull; mask &= mask - 1;
                const int s0e = __builtin_amdgcn_readlane(myslot, e0), s1e = __builtin_amdgcn_readlane(myslot, e1);
                const float a0 = __uint_as_float(__builtin_amdgcn_readlane(__float_as_uint(myaff), e0)), a1 = two ? __uint_as_float(__builtin_amdgcn_readlane(__float_as_uint(myaff), e1)) : 0.f;
                f32x4 y0[8], y1[8]; row_ld_bf16(Y + (size_t)s0e * D, y0, f.lane); row_ld_bf16(Y + (size_t)s1e * D, y1, f.lane);
#pragma unroll
                for (int j = 0; j < 8; ++j) acc[j] += y0[j] * a0 + y1[j] * a1; }
            const float rstd = row_rstd(acc);
#pragma unroll
            for (int j = 0; j < 8; ++j) { const int e = (j * 64 + f.lane) * 4; const f32x4 gv = *(const LAS f32x4*)(lv + e), nv = *(const LAS f32x4*)(lv + 2048 + e); xs[j] = xs[j] + gv * (acc[j] * rstd * nv); }
            if (l == DEPTH - 1) { const int b = row / TS, t = row % TS; float* dst = a.out + ((size_t)b * SEQ + (t - CTXL)) * D;
#pragma unroll
                for (int j = 0; j < 8; ++j) *(f32x4*)(dst + (j * 64 + f.lane) * 4) = xs[j]; }
            else row_st_bf16(XS + (size_t)row * D, xs, f.lane);
            if (l < DEPTH - 1) {
                const float rstd2 = row_rstd(xs); f32x4 y[8];
#pragma unroll
                for (int j = 0; j < 8; ++j) { const int e = (j * 64 + f.lane) * 4; const f32x4 gg = *(const LAS f32x4*)(lv + 4096 + e), sh = *(const LAS f32x4*)(lv + 6144 + e), sc = *(const LAS f32x4*)(lv + 8192 + e); y[j] = xs[j] * rstd2 * gg * (sc + 1.0f) + sh; }
                row_st_bf16(H + (size_t)row * D, y, f.lane); }
        }
        s0 = s1;
    }
    __syncthreads();
}

constexpr int LDS_BYTES = 147456, MISC_OFF = 147456 - 64;
constexpr int NPH_LAYER = 15, NPHASES = 1 + DEPTH * NPH_LAYER;
__global__ void __launch_bounds__(NTHR, 2) mega(Args args) {
    extern __shared__ __attribute__((aligned(16))) unsigned char lds_raw[];
    ArgView av; av.out = args.out;
    F f; f.lds = (LAS unsigned char*)lds_raw; f.a = &av; f.ws = args.ws;
    f.tid = threadIdx.x; f.lane = f.tid & 63; f.wave = __builtin_amdgcn_readfirstlane(f.tid >> 6);
    f.G = gridDim.x; { const int bx = blockIdx.x; f.vcu = (f.G % 8 == 0) ? (bx % 8) * (f.G / 8) + bx / 8 : bx; }
    f.gw = f.vcu * NWAVES + f.wave; f.NGW = f.G * NWAVES;
    volatile LAS unsigned* MISC = (volatile LAS unsigned*)(f.lds + MISC_OFF);
    if (f.tid < 16) MISC[f.tid] = 0u;
    __syncthreads();
    const int lo = args.ph_lo, hi = args.ph_hi;
    unsigned* barw = (unsigned*)(f.ws + WS_CTL) + CW_BAR;
    XcdBarrier bar; bar.bar = barw; bar.x = 0; bar.st = nullptr;
    if (hi - lo > 1) bar = xcd_barrier_post(barw, MISC);
#ifndef PH_MASK
#define PH_MASK 0xFFFFFFFFu
#endif
#define PHE(j) ((PH_MASK >> (j)) & 1u)
#ifndef REP_MASK
#define REP_MASK 0u
#endif
#define REPS(j) (1 + (int)((REP_MASK >> (j)) & 1u))
#define IN(k) (lo <= (k) && (k) < hi)
#define SEAM(k) do { if (IN(k) && IN((k) + 1)) xcd_barrier(bar); } while (0)
    unsigned char* T = f.ws + WS_T;
    if (PHE(0) && IN(0)) for (int rep_ = 0; rep_ < REPS(0); ++rep_) { if (rep_) xcd_barrier(bar); phase_prologue(f); }
    SEAM(0);
    for (int l = 0; l < DEPTH; ++l) {
        const int pb = 1 + l * NPH_LAYER; const bool keep = l < DEPTH - 1;
        const unsigned char* wb = f.ws + WS_WB + (size_t)l * WB_BYTES;
        if (l == 0) { if (PHE(1) && IN(pb + 0)) for (int rep_ = 0; rep_ < REPS(1); ++rep_) { if (rep_) xcd_barrier(bar); phase_norm1(f, l); }
        SEAM(pb + 0); }
        if (PHE(2) && IN(pb + 1)) for (int rep_ = 0; rep_ < REPS(2); ++rep_) { if (rep_) xcd_barrier(bar);
            SchedP S{(const char*)(f.ws + WS_H), (const char*)(wb + WB_WIN), f.G, (int)blockIdx.x, keep};
            EpiP E{(bf16_t*)(T + T_PA), (bf16_t*)(T + T_PG)};
            { const F g = refresh(f); pg8::gemm_phase(g.lds, pg8::Desc{2048, 2048, 2048}, S, E, g.tid); }
            if (l == 0 && rep_ == 0) { int n_idle; const int rk_ = tail_rank((R / 256) * NP_TILES, f.G, n_idle); __syncthreads();
                if (rk_ >= 0) { const F g = refresh(f); cvt_wb(g, 1, rk_ * NWAVES + g.wave, n_idle * NWAVES); }
                else if (((R / 256) * NP_TILES) % f.G == 0) { const F g = refresh(f); cvt_wb(g, 1, g.gw, g.NGW); } }
            if (l == 1 && rep_ == 0) { int n_idle; const int rk_ = tail_rank(NBATCH * 16 * NP_TILES + NBATCH * 15, f.G, n_idle); __syncthreads();
                if (rk_ >= 0) { const F g = refresh(f); cvt_moe(g, 1, rk_ * NWAVES + g.wave, n_idle * NWAVES, 10); }
                else if ((NBATCH * 16 * NP_TILES + NBATCH * 15) % f.G == 0) { const F g = refresh(f); cvt_moe(g, 1, g.gw, g.NGW, 10); } }
        }
        SEAM(pb + 1);
        if (PHE(3) && IN(pb + 2)) for (int rep_ = 0; rep_ < REPS(3); ++rep_) { if (rep_) xcd_barrier(bar); phase_prep_rows(f, l); }
        SEAM(pb + 2);
        if (PHE(5) && IN(pb + 4)) for (int rep_ = 0; rep_ < REPS(5); ++rep_) { if (rep_) xcd_barrier(bar);
#ifndef MIX_MASK
#define MIX_MASK 7
#endif
            const bool scan_first = (((int)blockIdx.x >> 3) & 1) != 0;
            for (int step = 0; step < 2; ++step) {
                if ((step == 0) == scan_first) { if ((MIX_MASK & 4) && rep_ == 0) phase_scanA(f, l); }
                else {
                    if (MIX_MASK & 1) phase_attn(f, keep);
                    __syncthreads();
                    if (MIX_MASK & 2) { SchedPool S{(const char*)(f.ws + WS_PL), (const char*)(wb + WB_WPG), f.G, (int)blockIdx.x, keep ? R / 256 : NBATCH * 16, keep};
                      EpiStore E{(bf16_t*)(T + T_PO), 1024, f.a->in[I_PSC] + (size_t)l * 1024};
                      { const F g = refresh(f); pg8::gemm_phase(g.lds, pg8::Desc{256, 1024, 256}, S, E, g.tid); } }
                }
                __syncthreads();
            }
        }
        SEAM(pb + 4);
        if (PHE(6) && IN(pb + 5)) for (int rep_ = 0; rep_ < REPS(6); ++rep_) { if (rep_) xcd_barrier(bar); phase_scanB(f); }
        SEAM(pb + 5);
        if (PHE(7) && IN(pb + 6)) for (int rep_ = 0; rep_ < REPS(7); ++rep_) { if (rep_) xcd_barrier(bar); phase_rwkv_post(f, l, keep); }
        SEAM(pb + 6);
        if (PHE(8) && IN(pb + 7)) for (int rep_ = 0; rep_ < REPS(8); ++rep_) { if (rep_) xcd_barrier(bar);
            SchedMerge S{(const char*)(T + T_AT), (const char*)(wb + WB_WA), f.G, (int)blockIdx.x, keep ? R / 256 : NBATCH * 16, keep};
            EpiMerge E{(const bf16_t*)(T + T_PG), (bf16_t*)(T + T_MG)};
            { const F g = refresh(f); pg8::gemm_phase(g.lds, pg8::Desc{1024, 1024, 1024}, S, E, g.tid); }
            if (keep && rep_ == 0) {
                int n_idle; const int rk_ = tail_rank((R / 256) * 8, f.G, n_idle); __syncthreads();
                if (rk_ >= 0) { const F g = refresh(f); cvt_moe(g, l, rk_ * NWAVES + g.wave, n_idle * NWAVES, 3); }
                else if (((R / 256) * 8) % f.G == 0) { const F g = refresh(f); cvt_moe(g, l, g.gw, g.NGW, 3); } }
        }
        SEAM(pb + 7);
        if (PHE(9) && IN(pb + 8)) for (int rep_ = 0; rep_ < REPS(9); ++rep_) { if (rep_) xcd_barrier(bar);
            SchedTiles S{(const char*)(T + T_MG), (const char*)(wb + WB_WOUT), (size_t)256 * 2048 * 2, (size_t)256 * 2048 * 2, f.G, (int)blockIdx.x, keep ? R / 256 : NBATCH * 16, 8, keep};
            EpiStore E{(bf16_t*)(T + T_MX), D, nullptr};
            { const F g = refresh(f); pg8::gemm_phase(g.lds, pg8::Desc{2048, 2048, 2048}, S, E, g.tid); }
            if (keep && rep_ == 0) { int n_idle; const int rk_ = tail_rank((R / 256) * 8, f.G, n_idle); __syncthreads();
                if (rk_ >= 0) { const F g = refresh(f); cvt_moe(g, l, rk_ * NWAVES + g.wave, n_idle * NWAVES, 12); }
                else if (((R / 256) * 8) % f.G == 0) { const F g = refresh(f); cvt_moe(g, l, g.gw, g.NGW, 12); } }
        }
        SEAM(pb + 8);
        if (PHE(10) && IN(pb + 9)) for (int rep_ = 0; rep_ < REPS(10); ++rep_) { if (rep_) xcd_barrier(bar); phase_resid1(f, l, keep); }
        SEAM(pb + 9);
        if (PHE(11) && IN(pb + 10)) for (int rep_ = 0; rep_ < REPS(11); ++rep_) { if (rep_) xcd_barrier(bar); phase_route(f, keep); }
        SEAM(pb + 10);
        if (PHE(13) && IN(pb + 12)) for (int rep_ = 0; rep_ < REPS(13); ++rep_) { if (rep_) xcd_barrier(bar);
            SchedMoeT<true> S{(const char*)(f.ws + WS_H), (const char*)moe_w(f, l), (const int*)(f.ws + WS_SLOTROW), (size_t)D * 2, (size_t)256 * 2048 * 2, (size_t)2048 * 2048 * 2, f.G, (int)blockIdx.x, keep ? 9 : 8};
            EpiSilu E{(bf16_t*)(T + T_HID)};
            { const F g = refresh(f); pg8::gemm_phase(g.lds, pg8::Desc{2048, 2048, 2048}, S, E, g.tid); }
            if (l == 0 && rep_ == 0) { int n_idle; const int rk_ = tail_rank(NE * 9 * 8, f.G, n_idle); __syncthreads();
                if (rk_ >= 0) { const F g = refresh(f); cvt_moe(g, 1, rk_ * NWAVES + g.wave, n_idle * NWAVES, 1); }
                else if ((NE * 9 * 8) % f.G == 0) { const F g = refresh(f); cvt_moe(g, 1, g.gw, g.NGW, 1); } }
        }
        SEAM(pb + 12);
        if (PHE(14) && IN(pb + 13)) for (int rep_ = 0; rep_ < REPS(14); ++rep_) { if (rep_) xcd_barrier(bar);
            SchedMoeT<false> S{(const char*)(T + T_HID), (const char*)(moe_w(f, l) + MOE_WGU_BYTES), (const int*)(f.ws + WS_SLOTROW), (size_t)FF * 2, (size_t)256 * 1024 * 2, (size_t)2048 * 1024 * 2, f.G, (int)blockIdx.x, keep ? 9 : 8};
            EpiStore E{(bf16_t*)(T + T_Y), D, nullptr};
            { const F g = refresh(f); pg8::gemm_phase(g.lds, pg8::Desc{1024, 1024, 1024}, S, E, g.tid); }
            if (l == 0 && rep_ == 0) { int n_idle; const int rk_ = tail_rank(NE * 9 * 8, f.G, n_idle); __syncthreads();
                if (rk_ >= 0) { const F g = refresh(f); cvt_moe(g, 1, rk_ * NWAVES + g.wave, n_idle * NWAVES, 4); }
                else if ((NE * 9 * 8) % f.G == 0) { const F g = refresh(f); cvt_moe(g, 1, g.gw, g.NGW, 4); } }
        }
        SEAM(pb + 13);
        if (PHE(15) && IN(pb + 14)) for (int rep_ = 0; rep_ < REPS(15); ++rep_) { if (rep_) xcd_barrier(bar); phase_resid2(f, l, keep); }
        SEAM(pb + 14);
    }
#undef IN
#undef SEAM
}

extern "C" void kernel_launch(void* const* d_in, const int* in_sizes, int n_in, void* d_out, int out_size, void* d_ws, size_t ws_size, hipStream_t stream) {
    static int grid = 0;
    if (grid == 0) {
        if (n_in != 32 || out_size != NBATCH * SEQ * D || ws_size < WS_END) { fprintf(stderr, "kernel_launch: unexpected problem: n_in %d out %d ws %zu (need %zu)\n", n_in, out_size, ws_size, (size_t)WS_END); grid = -1; return; }
        int dev = 0, cus = 0, per_cu = 0;
        if (hipGetDevice(&dev) != hipSuccess || hipDeviceGetAttribute(&cus, hipDeviceAttributeMultiprocessorCount, dev) != hipSuccess) { grid = -1; return; }
        if (hipFuncSetAttribute((const void*)mega, hipFuncAttributeMaxDynamicSharedMemorySize, LDS_BYTES) != hipSuccess) { fprintf(stderr, "kernel_launch: hipFuncSetAttribute failed\n"); grid = -1; return; }
        if (hipOccupancyMaxActiveBlocksPerMultiprocessor(&per_cu, (const void*)mega, NTHR, LDS_BYTES) != hipSuccess || per_cu < 1) fprintf(stderr, "kernel_launch: occupancy query says %d\n", per_cu);
        (void)hipGetLastError();
        grid = cus;
    }
    if (grid < 0) return;
    if (hipMemsetAsync((char*)d_ws + WS_CTL, 0, CTL_BYTES, stream) != hipSuccess) return;
    Args a{};
    for (int i = 0; i < 32; ++i) a.in[i] = (const float*)d_in[i];
    a.out = (float*)d_out; a.ws = (unsigned char*)d_ws;
#if N_LAUNCH_MODE == 1
    a.ph_lo = 0; a.ph_hi = NPHASES;
    hipLaunchKernelGGL(mega, dim3(grid), dim3(NTHR), LDS_BYTES, stream, a);
#else
    for (int p = 0; p < NPHASES; ++p) { a.ph_lo = p; a.ph_hi = p + 1; hipLaunchKernelGGL(mega, dim3(grid), dim3(NTHR), LDS_BYTES, stream, a); }
#endif
    const hipError_t le = hipPeekAtLastError();
    if (le != hipSuccess) fprintf(stderr, "kernel_launch: launch failed: %s\n", hipGetErrorName(le));
}
```
